# Optimizing an MI355X kernel written in HIP

```python
import math
import jax, jax.numpy as jnp
from jax import lax
import numpy as np


D_MODEL = 1024
BATCH = 4
SEQ = 8192
DEPTH = 4

N_MIXERS = 3
GRID_W = 64
EPS = 1e-6
N_HEADS = 16
HEAD_DIM = D_MODEL // N_HEADS
N_KV_HEADS = 4
Q_BLOCK = 128
ROPE_THETA = 10000.0
HY_ORDER = 2
HY_EMB_DIM = 33
HY_FILTER_WIDTH = 64
HY_FAST_DECAY = 0.3
HY_SLOW_DECAY = 1.5
HY_TARGET = 1e-2
S5_GROUP = 16
S5_GROUPS = D_MODEL // S5_GROUP
S5_STATE = 64
S5_DT_MIN = 1e-3
S5_DT_MAX = 1e-1
D_FF = 2816

kernel_name = 'hybrid_attn_hyena_s5_encoder'


def rmsnorm(x, g):
    xf = x.astype(jnp.float32)
    y = xf * lax.rsqrt(jnp.mean(xf * xf, axis=-1, keepdims=True) + EPS)
    return (y * g.astype(jnp.float32)).astype(x.dtype)


def dwconv3(x, w, b):
    L = x.shape[1]
    xp = jnp.pad(x, ((0, 0), (1, 1), (0, 0)))
    return xp[:, :L] * w[0] + xp[:, 1:L + 1] * w[1] + xp[:, 2:] * w[2] + b


def axial_rope_tables(L):
    rows = L // GRID_W
    n_freq = HEAD_DIM // 4
    inv = 1.0 / (ROPE_THETA ** (jnp.arange(n_freq, dtype=jnp.float32) / n_freq))
    r = jnp.arange(rows, dtype=jnp.float32)
    col = jnp.arange(GRID_W, dtype=jnp.float32)
    ang_r = jnp.broadcast_to(r[:, None, None] * inv, (rows, GRID_W, n_freq))
    ang_c = jnp.broadcast_to(col[None, :, None] * inv, (rows, GRID_W, n_freq))
    ang = jnp.concatenate([ang_r, ang_c], axis=-1).reshape(L, 2 * n_freq)
    return jnp.cos(ang), jnp.sin(ang)


def apply_rope(x, cos, sin):
    xf = x.astype(jnp.float32).reshape(x.shape[:-1] + (HEAD_DIM // 2, 2))
    x0, x1 = xf[..., 0], xf[..., 1]
    c = cos[None, :, None, :]
    s = sin[None, :, None, :]
    out = jnp.stack([x0 * c - x1 * s, x0 * s + x1 * c], axis=-1).reshape(x.shape)
    return out.astype(x.dtype)


def attention_mixer(h, w_qkv, w_o, q_gain, k_gain, cos, sin):
    Bsz, L, _ = h.shape
    G = N_HEADS // N_KV_HEADS
    qkv = h @ w_qkv
    q, k, v = jnp.split(qkv, [N_HEADS * HEAD_DIM, (N_HEADS + N_KV_HEADS) * HEAD_DIM], axis=-1)
    q = q.reshape(Bsz, L, N_HEADS, HEAD_DIM)
    k = k.reshape(Bsz, L, N_KV_HEADS, HEAD_DIM)
    v = v.reshape(Bsz, L, N_KV_HEADS, HEAD_DIM)
    q = apply_rope(rmsnorm(q, q_gain), cos, sin)
    k = apply_rope(rmsnorm(k, k_gain), cos, sin)
    nb = L // Q_BLOCK
    qb = q.reshape(Bsz, nb, Q_BLOCK, N_KV_HEADS, G, HEAD_DIM).transpose(1, 0, 2, 3, 4, 5)
    scale = HEAD_DIM ** -0.5

    def block(q_blk):
        s = jnp.einsum('bqkgd,bskd->bkgqs', q_blk, k, preferred_element_type=jnp.float32) * scale
        p = jax.nn.softmax(s, axis=-1).astype(v.dtype)
        return jnp.einsum('bkgqs,bskd->bqkgd', p, v)

    o = lax.map(block, qb)
    o = o.transpose(1, 0, 2, 3, 4, 5).reshape(Bsz, L, N_HEADS * HEAD_DIM)
    return o @ w_o


def hyena_pos_features(L):
    t = jnp.linspace(0.0, 1.0, L, dtype=jnp.float32)[:, None]
    bands = (HY_EMB_DIM - 1) // 2
    w = 2.0 * math.pi * jnp.arange(L, dtype=jnp.float32) / L
    f = jnp.linspace(1e-4, bands - 1, bands, dtype=jnp.float32)
    ang = w[:, None] * f[None, :]
    z = jnp.concatenate([t, jnp.cos(ang), -jnp.sin(ang)], axis=-1)
    deltas = jnp.abs(jnp.linspace(math.log(HY_TARGET) / HY_SLOW_DECAY,
                                  math.log(HY_TARGET) / HY_FAST_DECAY, D_MODEL, dtype=jnp.float32))
    decay = jnp.exp(-t * deltas[None, :])
    return z, decay


def hyena_mixer(h, w_in, conv_w, conv_b, f_w1, f_b1, f_w2, f_b2, f_w3, f_freq, skip, w_out, z, decay):
    Bsz, L, D = h.shape
    u = dwconv3(h @ w_in, conv_w, conv_b)
    v, x1, x2 = jnp.split(u, 3, axis=-1)
    a = jnp.sin(f_freq * (z @ f_w1 + f_b1))
    a = jnp.sin(f_freq * (a @ f_w2 + f_b2))
    filt = (a @ f_w3).astype(jnp.float32).reshape(L, HY_ORDER, 2, D) * decay[:, None, None, :]
    fwd = filt[:, :, 0]
    bwd = filt[:, :, 1]
    k2 = jnp.concatenate([fwd, jnp.zeros_like(fwd[:1]), bwd[1:][::-1]], axis=0)
    k2 = k2 / jnp.sum(jnp.abs(k2), axis=0, keepdims=True)
    kf = jnp.fft.rfft(k2, axis=0)
    gates = (x1, x2)
    zc = v
    for o in range(HY_ORDER):
        zf = jnp.fft.rfft(zc.astype(jnp.float32), n=2 * L, axis=1)
        y = jnp.fft.irfft(zf * kf[None, :, o], n=2 * L, axis=1)[:, :L]
        zc = gates[o] * (y.astype(h.dtype) + skip[o] * zc)
    return zc @ w_out


def s5_direction(u, A_re, A_im, log_dt, B_re, B_im, C_re, C_im, reverse):
    L = u.shape[1]
    lam = lax.complex(jnp.minimum(A_re.astype(jnp.float32), -1e-4), A_im.astype(jnp.float32))
    dt = jnp.exp(log_dt.astype(jnp.float32))[:, None]
    lam_bar = jnp.exp(lam * dt)
    b_c = lax.complex(B_re.astype(jnp.float32), B_im.astype(jnp.float32))
    b_bar = ((lam_bar - 1.0) / lam)[..., None] * b_c
    bu = jnp.einsum('blgh,gph->blgp', u.astype(jnp.complex64), b_bar)
    a = jnp.broadcast_to(lam_bar[None, None], (1, L) + lam_bar.shape)

    def combine(e1, e2):
        a1, b1 = e1
        a2, b2 = e2
        return a2 * a1, a2 * b1 + b2

    _, xs = lax.associative_scan(combine, (a, bu), axis=1, reverse=reverse)
    c_c = lax.complex(C_re.astype(jnp.float32), C_im.astype(jnp.float32))
    return jnp.einsum('blgp,ghp->blgh', xs, c_c).real


def s5_mixer(h, A_re, A_im, log_dt, B_re, B_im, C_re, C_im, d_skip, w_glu):
    Bsz, L, D = h.shape
    hf = h.astype(jnp.float32)
    u = hf.reshape(Bsz, L, S5_GROUPS, S5_GROUP)
    y_f = s5_direction(u, A_re[0], A_im[0], log_dt[0], B_re[0], B_im[0], C_re[0], C_im[0], False)
    y_b = s5_direction(u, A_re[1], A_im[1], log_dt[1], B_re[1], B_im[1], C_re[1], C_im[1], True)
    y = (y_f + y_b).reshape(Bsz, L, D) + d_skip.astype(jnp.float32) * hf
    y = jax.nn.gelu(y.astype(h.dtype))
    g_a, g_b = jnp.split(y @ w_glu, 2, axis=-1)
    return g_a * jax.nn.sigmoid(g_b)


def conv_ffn(h, w_up, conv_w, conv_b, w_down):
    gate, val = jnp.split(h @ w_up, 2, axis=-1)
    gate = dwconv3(gate, conv_w, conv_b)
    return (jax.nn.silu(gate) * val) @ w_down


def setup_inputs(seed: int = 0) -> dict:
    key = jax.random.key(seed)
    ks = iter(jax.random.split(key, 48))
    f32 = jnp.float32

    def nrm(shape, scale):
        return jax.random.normal(next(ks), shape, f32) * scale

    n_attn = len(range(0, DEPTH, N_MIXERS))
    n_hy = len(range(1, DEPTH, N_MIXERS))
    n_s5 = len(range(2, DEPTH, N_MIXERS))
    D = D_MODEL
    G, P, Hg = S5_GROUPS, S5_STATE, S5_GROUP
    qkv_w = (N_HEADS + 2 * N_KV_HEADS) * HEAD_DIM
    return {
        'x': nrm((BATCH, SEQ, D), 1.0),
        'c': nrm((BATCH, D), 1.0),
        'ada_w': nrm((DEPTH, D, 6 * D), 0.5 * D ** -0.5),
        'ada_b': nrm((DEPTH, 6 * D), 0.02),
        'norm1_g': 1.0 + nrm((DEPTH, D), 0.02),
        'norm2_g': 1.0 + nrm((DEPTH, D), 0.02),
        'final_g': 1.0 + nrm((D,), 0.02),
        'attn_w_qkv': nrm((n_attn, D, qkv_w), D ** -0.5),
        'attn_w_o': nrm((n_attn, N_HEADS * HEAD_DIM, D), D ** -0.5),
        'attn_q_gain': 1.0 + nrm((n_attn, HEAD_DIM), 0.02),
        'attn_k_gain': 1.0 + nrm((n_attn, HEAD_DIM), 0.02),
        'hy_w_in': nrm((n_hy, D, 3 * D), D ** -0.5),
        'hy_conv_w': nrm((n_hy, 3, 3 * D), 3 ** -0.5),
        'hy_conv_b': nrm((n_hy, 3 * D), 0.02),
        'hy_f_w1': nrm((n_hy, HY_EMB_DIM, HY_FILTER_WIDTH), HY_EMB_DIM ** -0.5),
        'hy_f_b1': nrm((n_hy, HY_FILTER_WIDTH), 0.1),
        'hy_f_w2': nrm((n_hy, HY_FILTER_WIDTH, HY_FILTER_WIDTH), HY_FILTER_WIDTH ** -0.5),
        'hy_f_b2': nrm((n_hy, HY_FILTER_WIDTH), 0.1),
        'hy_f_w3': nrm((n_hy, HY_FILTER_WIDTH, HY_ORDER * 2 * D), HY_FILTER_WIDTH ** -0.5),
        'hy_f_freq': 1.0 + nrm((n_hy, HY_FILTER_WIDTH), 0.02),
        'hy_skip': nrm((n_hy, HY_ORDER, D), 1.0),
        'hy_w_out': nrm((n_hy, D, D), D ** -0.5),
        's5_A_re': -0.5 + nrm((n_s5, 2, G, P), 0.01),
        's5_A_im': math.pi * jnp.arange(P, dtype=f32) + nrm((n_s5, 2, G, P), 0.01),
        's5_log_dt': jax.random.uniform(next(ks), (n_s5, 2, G), f32, math.log(S5_DT_MIN), math.log(S5_DT_MAX)),
        's5_B_re': nrm((n_s5, 2, G, P, Hg), (2 * Hg) ** -0.5),
        's5_B_im': nrm((n_s5, 2, G, P, Hg), (2 * Hg) ** -0.5),
        's5_C_re': nrm((n_s5, 2, G, Hg, P), (2 * P) ** -0.5),
        's5_C_im': nrm((n_s5, 2, G, Hg, P), (2 * P) ** -0.5),
        's5_D': nrm((n_s5, D), 1.0),
        's5_w_glu': nrm((n_s5, D, 2 * D), D ** -0.5),
        'ffn_w_up': nrm((DEPTH, D, 2 * D_FF), D ** -0.5),
        'ffn_conv_w': nrm((DEPTH, 3, D_FF), 3 ** -0.5),
        'ffn_conv_b': nrm((DEPTH, D_FF), 0.02),
        'ffn_w_down': nrm((DEPTH, D_FF, D), D_FF ** -0.5),
    }


def reference(x, c, ada_w, ada_b, norm1_g, norm2_g, final_g,
              attn_w_qkv, attn_w_o, attn_q_gain, attn_k_gain,
              hy_w_in, hy_conv_w, hy_conv_b, hy_f_w1, hy_f_b1, hy_f_w2, hy_f_b2, hy_f_w3, hy_f_freq,
              hy_skip, hy_w_out,
              s5_A_re, s5_A_im, s5_log_dt, s5_B_re, s5_B_im, s5_C_re, s5_C_im, s5_D, s5_w_glu,
              ffn_w_up, ffn_conv_w, ffn_conv_b, ffn_w_down):
    L = x.shape[1]
    cos, sin = axial_rope_tables(L)
    z, decay = hyena_pos_features(L)
    c_act = jax.nn.silu(c)
    for i in range(DEPTH):
        m, j = i % N_MIXERS, i // N_MIXERS
        mod = (c_act @ ada_w[i] + ada_b[i])[:, None, :]
        sh1, sc1, g1, sh2, sc2, g2 = jnp.split(mod, 6, axis=-1)
        h = rmsnorm(x, norm1_g[i]) * (1.0 + sc1) + sh1
        if m == 0:
            y = attention_mixer(h, attn_w_qkv[j], attn_w_o[j], attn_q_gain[j], attn_k_gain[j], cos, sin)
        elif m == 1:
            y = hyena_mixer(h, hy_w_in[j], hy_conv_w[j], hy_conv_b[j], hy_f_w1[j], hy_f_b1[j],
                            hy_f_w2[j], hy_f_b2[j], hy_f_w3[j], hy_f_freq[j], hy_skip[j], hy_w_out[j],
                            z, decay)
        else:
            y = s5_mixer(h, s5_A_re[j], s5_A_im[j], s5_log_dt[j], s5_B_re[j], s5_B_im[j],
                         s5_C_re[j], s5_C_im[j], s5_D[j], s5_w_glu[j])
        x = x + g1 * y
        h = rmsnorm(x, norm2_g[i]) * (1.0 + sc2) + sh2
        x = x + g2 * conv_ffn(h, ffn_w_up[i], ffn_conv_w[i], ffn_conv_b[i], ffn_w_down[i])
    return rmsnorm(x, final_g)
```

```cpp
#include <hip/hip_runtime.h>
#include <hip/hip_cooperative_groups.h>
#include <hip/hip_bf16.h>
#include <cstdio>
#include <cstdint>
#include <cmath>
namespace cg = cooperative_groups;

#define LAS __attribute__((address_space(3)))
typedef unsigned short bf16_t;
typedef short bf16x8 __attribute__((ext_vector_type(8)));
typedef float f32x4 __attribute__((ext_vector_type(4)));
typedef float f32x2 __attribute__((ext_vector_type(2)));
typedef unsigned u32x4 __attribute__((ext_vector_type(4)));
typedef unsigned u32x2 __attribute__((ext_vector_type(2)));

constexpr int NB = 4, SEQ = 8192, DM = 1024, TOK = NB * SEQ, DFF = 2816, NHEAD = 16, NKV = 4, HD = 64, NQKV = 1536;
constexpr float EPS = 1e-6f;
constexpr int NWAVES = 8;

__device__ __forceinline__ unsigned f2bf(float f) { unsigned u = __builtin_bit_cast(unsigned, f); return (u + 0x7fffu + ((u >> 16) & 1u)) >> 16; }
__device__ __forceinline__ unsigned pk2(float lo, float hi) { return f2bf(lo) | (f2bf(hi) << 16); }
__device__ __forceinline__ float bf2f(unsigned short b) { return __builtin_bit_cast(float, (unsigned)b << 16); }
__device__ __forceinline__ float bflo(unsigned w) { return __builtin_bit_cast(float, w << 16); }
__device__ __forceinline__ float bfhi(unsigned w) { return __builtin_bit_cast(float, w & 0xffff0000u); }
__device__ __forceinline__ float bperm(float v, int srclane) { return __builtin_bit_cast(float, __builtin_amdgcn_ds_bpermute(srclane << 2, __builtin_bit_cast(int, v))); }
__device__ __forceinline__ float dpp_rotr1(float v) { return __builtin_bit_cast(float, __builtin_amdgcn_update_dpp(0, __builtin_bit_cast(int, v), 0x121, 0xf, 0xf, true)); }
__device__ __forceinline__ float dpp_rotl1(float v) { return __builtin_bit_cast(float, __builtin_amdgcn_update_dpp(0, __builtin_bit_cast(int, v), 0x12F, 0xf, 0xf, true)); }
__device__ __forceinline__ float dpp_shr1(float edge, float v) { return __builtin_bit_cast(float, __builtin_amdgcn_update_dpp(__builtin_bit_cast(int, edge), __builtin_bit_cast(int, v), 0x111, 0xf, 0xf, false)); }
__device__ __forceinline__ float dpp_shl1(float edge, float v) { return __builtin_bit_cast(float, __builtin_amdgcn_update_dpp(__builtin_bit_cast(int, edge), __builtin_bit_cast(int, v), 0x101, 0xf, 0xf, false)); }
__device__ __forceinline__ float wave_sum(float v, int lane) {
#pragma unroll
    for (int o = 1; o < 64; o <<= 1) v += bperm(v, lane ^ o);
    return v;
}
__device__ __forceinline__ int ltid() { int t = threadIdx.x; asm volatile("" : "+v"(t)); return t; }
__device__ __forceinline__ int lbid() { int b = blockIdx.x; asm volatile("" : "+s"(b)); return b; }
__device__ __forceinline__ int lgrid() { int g = gridDim.x; asm volatile("" : "+s"(g)); return g; }
__device__ __forceinline__ float sigmoidf_(float x) { return __builtin_amdgcn_rcpf(1.0f + __builtin_amdgcn_exp2f(x * -1.4426950408889634f)); }
__device__ __forceinline__ float gelu_tanh(float x) { const float u = 0.7978845608028654f * (x + 0.044715f * x * x * x); return x * sigmoidf_(2.0f * u); }

namespace pg8 {
constexpr int BM = 256, BK = 64, HALF = 128, HTB = HALF * BK * 2, STAGE_BYTES = 8 * HTB, NXCD = 8, WGM = 8;
__host__ __device__ __forceinline__ int lds_byte(int r, int c) { const int st = (r >> 4) * 2 + (c >> 5), rr = r & 15, cc = c & 31, ob = rr * 64 + cc * 2; return st * 1024 + (ob ^ (((ob >> 9) & 1) << 5)); }
__host__ __device__ __forceinline__ void stage_rc(int b, int& R, int& C) { const int st = b / 1024, sb = b % 1024, swz = sb ^ (((sb >> 9) & 1) << 5); R = (st >> 1) * 16 + swz / 64; C = (st & 1) * 32 + (swz % 64) / 2; }
__host__ __device__ __forceinline__ int perm32(int rho) { const int n = rho >> 4, i = rho & 15; return 8 * (i >> 2) + 4 * n + (i & 3); }

struct Unit { int pm, pn, g; };
struct Gemm { const char* A; const char* B; int nt; int a_row, a_seg; size_t a_kstep, a_g; int ldb; size_t b_g; };
struct Sched {
    int nM, nN, ng, G, c;
    __device__ __forceinline__ bool next(int i, Unit& u) const {
        const long L = (long)i * G + c; const int per = nM * nN; if (L >= (long)per * ng) return false;
        if (ng == 1) {
            int wgid = (int)L; { const int q = per / NXCD, r = per % NXCD, xcd = wgid % NXCD, off = wgid / NXCD; wgid = (xcd < r ? xcd * (q + 1) : r * (q + 1) + (xcd - r) * q) + off; }
            const int nig = WGM * nN, gid = wgid / nig, fm = gid * WGM, gsz = (nM - fm) < WGM ? (nM - fm) : WGM;
            u.pm = fm + ((wgid % nig) % gsz); u.pn = (wgid % nig) / gsz; u.g = 0;
        } else { u.g = (int)(L / per); const int r = (int)(L - (long)u.g * per); u.pm = r % nM; u.pn = r / nM; }
        return true;
    }
};
__device__ __forceinline__ unsigned cvt_pk_bf16(float lo, float hi) { unsigned r; asm volatile("v_cvt_pk_bf16_f32 %0, %1, %2" : "=v"(r) : "v"(lo), "v"(hi)); return r; }

constexpr int NBIAS = 27136;
__device__ __forceinline__ void apply_rstd_bias(f32x4 (&acc)[2][2][4][2], const float* ss, const float* bias, int rowt, int colt, bool perm, int wr, int wc, int fr, int fq, int bstride = NBIAS) {
    const int b = rowt / SEQ; const float* bp = bias + (size_t)b * bstride + colt + wc * 32 + (perm ? 8 * fq : 4 * fq);
    float rs[2][4];
#pragma unroll
    for (int ai = 0; ai < 2; ++ai)
#pragma unroll
        for (int m = 0; m < 4; ++m) rs[ai][m] = __builtin_amdgcn_rsqf(ss[rowt + ai * HALF + wr * 64 + m * 16 + fr] * (1.0f / DM) + EPS);
#pragma unroll
    for (int bj = 0; bj < 2; ++bj)
#pragma unroll
        for (int n = 0; n < 2; ++n) { const f32x4 bv = *(const f32x4*)(bp + bj * HALF + (perm ? 4 * n : 16 * n));
#pragma unroll
            for (int ai = 0; ai < 2; ++ai)
#pragma unroll
                for (int m = 0; m < 4; ++m) acc[ai][bj][m][n] = acc[ai][bj][m][n] * rs[ai][m] + bv; }
}
struct EpiBf16 {
    static constexpr bool PERM = true;
    bf16_t* O; int ldc; const float* ss; const float* bias; int bstride;
    __device__ __forceinline__ void operator()(f32x4 (&acc)[2][2][4][2], const Unit& u, int wr, int wc, int fr, int fq) const {
        apply_rstd_bias(acc, ss, bias, u.pm * BM, u.pn * BM, true, wr, wc, fr, fq, bstride);
        asm volatile("" ::: "memory"); __builtin_amdgcn_sched_barrier(0);
        const int row0 = u.pm * BM + wr * 64 + fr; const int col0 = u.pn * BM + wc * 32 + 8 * fq;
#pragma unroll
        for (int ai = 0; ai < 2; ++ai)
#pragma unroll
            for (int m = 0; m < 4; ++m) { bf16_t* rowp = O + (size_t)(row0 + ai * HALF + m * 16) * ldc + col0;
#pragma unroll
                for (int bj = 0; bj < 2; ++bj) { const f32x4 v0 = acc[ai][bj][m][0], v1 = acc[ai][bj][m][1];
                    u32x4 w; w.x = cvt_pk_bf16(v0[0], v0[1]); w.y = cvt_pk_bf16(v0[2], v0[3]); w.z = cvt_pk_bf16(v1[0], v1[1]); w.w = cvt_pk_bf16(v1[2], v1[3]);
                    *(u32x4*)(rowp + bj * HALF) = w; } }
    }
};
struct EpiBf16T {
    static constexpr bool PERM = true;
    bf16_t* O; const float* ss; const float* bias;
    __device__ __forceinline__ void operator()(f32x4 (&acc)[2][2][4][2], const Unit& u, int wr, int wc, int fr_, int fq_) const {
        int fr = fr_, fq = fq_; asm volatile("" : "+v"(fr), "+v"(fq));
        const int tok0 = u.pn * BM + wc * 32 + 8 * fq; const int b = (u.pn * BM) / SEQ; const float* bp = bias + (size_t)b * NBIAS;
        f32x4 rs[2][2];
#pragma unroll
        for (int bj = 0; bj < 2; ++bj)
#pragma unroll
            for (int n = 0; n < 2; ++n) { const f32x4 sv = *(const f32x4*)(ss + tok0 + bj * HALF + 4 * n);
#pragma unroll
                for (int e = 0; e < 4; ++e) rs[bj][n][e] = __builtin_amdgcn_rsqf(sv[e] * (1.0f / DM) + EPS); }
#pragma unroll
        for (int ai = 0; ai < 2; ++ai)
#pragma unroll
            for (int m = 0; m < 4; ++m) { const int c = u.pm * BM + ai * HALF + wr * 64 + m * 16 + fr; const float bv = bp[c];
#pragma unroll
                for (int bj = 0; bj < 2; ++bj) { const f32x4 v0 = acc[ai][bj][m][0] * rs[bj][0] + bv, v1 = acc[ai][bj][m][1] * rs[bj][1] + bv;
                    *(u32x4*)(O + (size_t)c * TOK + tok0 + bj * HALF) = (u32x4){cvt_pk_bf16(v0[0], v0[1]), cvt_pk_bf16(v0[2], v0[3]), cvt_pk_bf16(v1[0], v1[1]), cvt_pk_bf16(v1[2], v1[3])}; } }
    }
};
struct EpiQkv {
    static constexpr bool PERM = true;
    bf16_t* Qn; bf16_t* Kn; bf16_t* Vc; const float* ss; const float* bias; int bstride; const float* qg; const float* kg; const f32x2* rope; LAS float* xch0; LAS float* xch1;
    __device__ __forceinline__ void operator()(f32x4 (&acc)[2][2][4][2], const Unit& u, int wr, int wc, int fr_, int fq_) const {
        int fr = fr_, fq = fq_; asm volatile("" : "+v"(fr), "+v"(fq));
        apply_rstd_bias(acc, ss, bias, u.pm * BM, u.pn * BM, true, wr, wc, fr, fq, bstride);
        asm volatile("" ::: "memory"); __builtin_amdgcn_sched_barrier(0);
        const int lane = fq * 16 + fr; const int cw = wc * 32 + 8 * fq;
        if (u.pn == 5) {
#pragma unroll
            for (int ai = 0; ai < 2; ++ai)
#pragma unroll
                for (int m = 0; m < 4; ++m) { const int r = u.pm * BM + ai * HALF + wr * 64 + m * 16 + fr;
#pragma unroll
                    for (int bj = 0; bj < 2; ++bj) { const f32x4 v0 = acc[ai][bj][m][0], v1 = acc[ai][bj][m][1];
                        *(u32x4*)(Vc + (size_t)r * 256 + bj * HALF + cw) = (u32x4){cvt_pk_bf16(v0[0], v0[1]), cvt_pk_bf16(v0[2], v0[3]), cvt_pk_bf16(v1[0], v1[1]), cvt_pk_bf16(v1[2], v1[3])}; } }
            return;
        }
#pragma unroll
        for (int ai = 0; ai < 2; ++ai)
#pragma unroll
            for (int m = 0; m < 4; ++m)
#pragma unroll
                for (int bj = 0; bj < 2; ++bj) { const f32x4 v0 = acc[ai][bj][m][0], v1 = acc[ai][bj][m][1];
                    float sq = (v0.x * v0.x + v0.y * v0.y) + (v0.z * v0.z + v0.w * v0.w) + (v1.x * v1.x + v1.y * v1.y) + (v1.z * v1.z + v1.w * v1.w);
                    sq += bperm(sq, lane ^ 16); sq += bperm(sq, lane ^ 32);
                    if (fq == 0) (bj ? xch1 : xch0)[(ai * HALF + wr * 64 + m * 16 + fr) * 4 + wc] = sq; }
        asm volatile("s_waitcnt lgkmcnt(0)" ::: "memory"); __builtin_amdgcn_s_barrier(); asm volatile("" ::: "memory");
        const bool isq = (u.pn < 4); const float* gp = (isq ? qg : kg) + (wc & 1) * 32 + 8 * fq;
        const f32x4 g0 = *(const f32x4*)gp, g1 = *(const f32x4*)(gp + 4);
        const float C2 = isq ? 0.125f * 1.4426950408889634f : 1.0f;
        const int pi0 = (wc & 1) * 16 + 4 * fq;
#pragma unroll
        for (int ai = 0; ai < 2; ++ai) {
            f32x4 rc0[4], rc1[4];
#pragma unroll
            for (int m = 0; m < 4; ++m) { const int t = (u.pm * BM + ai * HALF + wr * 64 + m * 16 + fr) & (SEQ - 1);
                rc0[m] = *(const f32x4*)(rope + (size_t)t * 32 + pi0); rc1[m] = *(const f32x4*)(rope + (size_t)t * 32 + pi0 + 2); }
#pragma unroll
            for (int m = 0; m < 4; ++m) { const int rt = ai * HALF + wr * 64 + m * 16 + fr; const int r = u.pm * BM + rt; const f32x4 cs0 = rc0[m], cs1 = rc1[m];
#pragma unroll
                for (int bj = 0; bj < 2; ++bj) { LAS float* xc = bj ? xch1 : xch0;
                    const float tot = xc[rt * 4 + wc] + xc[rt * 4 + (wc ^ 1)];
                    const float rs = __builtin_amdgcn_rsqf(tot * (1.0f / 64.0f) + EPS) * C2;
                    const f32x4 v0 = acc[ai][bj][m][0] * g0 * rs, v1 = acc[ai][bj][m][1] * g1 * rs;
                    const float o0 = v0.x * cs0.x - v0.y * cs0.y, o1 = v0.x * cs0.y + v0.y * cs0.x, o2 = v0.z * cs0.z - v0.w * cs0.w, o3 = v0.z * cs0.w + v0.w * cs0.z;
                    const float o4 = v1.x * cs1.x - v1.y * cs1.y, o5 = v1.x * cs1.y + v1.y * cs1.x, o6 = v1.z * cs1.z - v1.w * cs1.w, o7 = v1.z * cs1.w + v1.w * cs1.z;
                    const u32x4 w = {cvt_pk_bf16(o0, o1), cvt_pk_bf16(o2, o3), cvt_pk_bf16(o4, o5), cvt_pk_bf16(o6, o7)};
                    if (isq) *(u32x4*)(Qn + (size_t)r * 1024 + u.pn * BM + bj * HALF + cw) = w; else *(u32x4*)(Kn + (size_t)r * 256 + bj * HALF + cw) = w; } }
            asm volatile("" ::: "memory"); }
    }
};
__device__ __forceinline__ float shfl_xor_l(float v, int mask, int lane) { return bperm(v, lane ^ mask); }
struct NextNorm { bf16_t* Hn; const float* gn; const float* scn; float* ssn; };
struct EpiRes {
    static constexpr bool PERM = true;
    float* X; const float* gate; int rowoff; NextNorm nn; const float* Xr;
    __device__ __forceinline__ void operator()(f32x4 (&acc)[2][2][4][2], const Unit& u, int wr, int wc, int fr, int fq) const {
        const int rbase = rowoff + u.pm * BM; const int b = rbase / SEQ; const float* gp = gate + (size_t)b * 6144;
        const int row0 = rbase + wr * 64 + fr, col0 = u.pn * BM + wc * 32 + 8 * fq;
#pragma unroll
        for (int ai = 0; ai < 2; ++ai)
#pragma unroll
            for (int mh = 0; mh < 2; ++mh) {
                f32x4 xv[2][2][2], gv[2][2];
#pragma unroll
                for (int mm = 0; mm < 2; ++mm) { const float* p = Xr + (size_t)(row0 + ai * HALF + (2 * mh + mm) * 16) * DM + col0;
#pragma unroll
                    for (int bj = 0; bj < 2; ++bj)
#pragma unroll
                        for (int n = 0; n < 2; ++n) xv[mm][bj][n] = *(const f32x4*)(p + bj * HALF + n * 4); }
#pragma unroll
                for (int bj = 0; bj < 2; ++bj)
#pragma unroll
                    for (int n = 0; n < 2; ++n) gv[bj][n] = *(const f32x4*)(gp + col0 + bj * HALF + n * 4);
                float sq[2] = {0.f, 0.f};
#pragma unroll
                for (int mm = 0; mm < 2; ++mm) { const int r = row0 + ai * HALF + (2 * mh + mm) * 16; float* p = X + (size_t)r * DM + col0;
#pragma unroll
                    for (int bj = 0; bj < 2; ++bj)
#pragma unroll
                        for (int n = 0; n < 2; ++n) { const f32x4 xn = xv[mm][bj][n] + gv[bj][n] * acc[ai][bj][2 * mh + mm][n]; *(f32x4*)(p + bj * HALF + n * 4) = xn; xv[mm][bj][n] = xn;
                            sq[mm] += (xn.x * xn.x + xn.y * xn.y) + (xn.z * xn.z + xn.w * xn.w); } }
                if (nn.ssn) {
#pragma unroll
                    for (int mm = 0; mm < 2; ++mm) { const int r = row0 + ai * HALF + (2 * mh + mm) * 16; float q = sq[mm]; q += shfl_xor_l(q, 16, fq * 16 + fr); q += shfl_xor_l(q, 32, fq * 16 + fr); if (fq == 0) atomicAdd(nn.ssn + r, q); }
                    if (nn.Hn) {
#pragma unroll
                        for (int bj = 0; bj < 2; ++bj) { const float* gq = nn.gn + col0 + bj * HALF; const float* sp = nn.scn + (size_t)b * 6144 + col0 + bj * HALF;
                            const f32x4 c0 = *(const f32x4*)gq * (*(const f32x4*)sp + 1.0f), c1 = *(const f32x4*)(gq + 4) * (*(const f32x4*)(sp + 4) + 1.0f);
#pragma unroll
                            for (int mm = 0; mm < 2; ++mm) { const int r = row0 + ai * HALF + (2 * mh + mm) * 16; const f32x4 h0 = xv[mm][bj][0] * c0, h1 = xv[mm][bj][1] * c1;
                                *(u32x4*)(nn.Hn + (size_t)r * DM + col0 + bj * HALF) = (u32x4){cvt_pk_bf16(h0.x, h0.y), cvt_pk_bf16(h0.z, h0.w), cvt_pk_bf16(h1.x, h1.y), cvt_pk_bf16(h1.z, h1.w)}; } } } }
                asm volatile("" ::: "memory"); }
    }
};
struct EpiGlu {
    static constexpr bool PERM = true;
    float* X; const float* gate; NextNorm nn;
    __device__ __forceinline__ void operator()(f32x4 (&acc)[2][2][4][2], const Unit& u, int wr, int wc, int fr, int fq) const {
        const int rbase = u.pm * BM; const int b = rbase / SEQ; const float* gp = gate + (size_t)b * 6144;
        const int row0 = rbase + wr * 64 + fr, col0 = u.pn * HALF + wc * 32 + 8 * fq;
        f32x4 gv[2], cs[2];
#pragma unroll
        for (int n = 0; n < 2; ++n) { gv[n] = *(const f32x4*)(gp + col0 + n * 4); cs[n] = *(const f32x4*)(nn.gn + col0 + n * 4) * (*(const f32x4*)(nn.scn + (size_t)b * 6144 + col0 + n * 4) + 1.0f); }
#pragma unroll
        for (int ai = 0; ai < 2; ++ai) {
            f32x4 xv[4][2];
#pragma unroll
            for (int m = 0; m < 4; ++m) { const float* p = X + (size_t)(row0 + ai * HALF + m * 16) * DM + col0;
#pragma unroll
                for (int n = 0; n < 2; ++n) xv[m][n] = *(const f32x4*)(p + n * 4); }
#pragma unroll
            for (int m = 0; m < 4; ++m) { const int r = row0 + ai * HALF + m * 16; float* p = X + (size_t)r * DM + col0; float sq = 0.f; f32x4 hv[2];
#pragma unroll
                for (int n = 0; n < 2; ++n) { f32x4 x4 = xv[m][n]; const f32x4 ga = acc[ai][0][m][n], gb = acc[ai][1][m][n];
#pragma unroll
                    for (int e = 0; e < 4; ++e) x4[e] += gv[n][e] * ga[e] * sigmoidf_(gb[e]);
                    *(f32x4*)(p + n * 4) = x4; sq += (x4.x * x4.x + x4.y * x4.y) + (x4.z * x4.z + x4.w * x4.w); hv[n] = x4 * cs[n]; }
                *(u32x4*)(nn.Hn + (size_t)r * DM + col0) = (u32x4){cvt_pk_bf16(hv[0].x, hv[0].y), cvt_pk_bf16(hv[0].z, hv[0].w), cvt_pk_bf16(hv[1].x, hv[1].y), cvt_pk_bf16(hv[1].z, hv[1].w)};
                sq += shfl_xor_l(sq, 16, fq * 16 + fr); sq += shfl_xor_l(sq, 32, fq * 16 + fr); if (fq == 0) atomicAdd(nn.ssn + r, sq); }
            asm volatile("" ::: "memory"); }
    }
};
struct EpiS1 {
    static constexpr bool PERM = true;
    bf16_t* Yi; float* S;
    __device__ __forceinline__ void operator()(f32x4 (&acc)[2][2][4][2], const Unit& u, int wr, int wc, int fr, int fq) const {
        const int row0 = u.pm * BM + wr * 64 + fr; const int cw = wc * 32 + 8 * fq;
#pragma unroll
        for (int ai = 0; ai < 2; ++ai)
#pragma unroll
            for (int m = 0; m < 4; ++m) { const int r = row0 + ai * HALF + m * 16;
#pragma unroll
                for (int bj = 0; bj < 2; ++bj) { const f32x4 v0 = acc[ai][bj][m][0], v1 = acc[ai][bj][m][1]; const int c = u.pn * BM + bj * HALF + cw;
                    if (u.pn < 2) { u32x4 w; w.x = cvt_pk_bf16(v0[0], v0[1]); w.y = cvt_pk_bf16(v0[2], v0[3]); w.z = cvt_pk_bf16(v1[0], v1[1]); w.w = cvt_pk_bf16(v1[2], v1[3]);
                        *(u32x4*)(Yi + ((size_t)(r * 32 + (c >> 4)) * DM + u.g * 16 + (c & 15))) = w; }
                    else { float* sp = S + ((size_t)(u.g * 1024 + r) * 256 + (c - 512)); *(f32x4*)sp = v0; *(f32x4*)(sp + 4) = v1; } } }
    }
};
struct EpiS2 {
    static constexpr bool PERM = true;
    bf16_t* Yi;
    __device__ __forceinline__ void operator()(f32x4 (&acc)[2][2][4][2], const Unit& u, int wr, int wc, int fr, int fq) const {
        const int row0 = u.pm * BM + wr * 64 + fr; const int cw = wc * 32 + 8 * fq;
#pragma unroll
        for (int ai = 0; ai < 2; ++ai) {
            u32x4 yv[4][2];
#pragma unroll
            for (int m = 0; m < 4; ++m)
#pragma unroll
                for (int bj = 0; bj < 2; ++bj) { const int r = row0 + ai * HALF + m * 16, c = u.pn * BM + bj * HALF + cw; yv[m][bj] = *(const u32x4*)(Yi + ((size_t)(r * 32 + (c >> 4)) * DM + u.g * 16 + (c & 15))); }
#pragma unroll
            for (int m = 0; m < 4; ++m)
#pragma unroll
                for (int bj = 0; bj < 2; ++bj) { const int r = row0 + ai * HALF + m * 16, c = u.pn * BM + bj * HALF + cw; const f32x4 v0 = acc[ai][bj][m][0], v1 = acc[ai][bj][m][1]; const u32x4 yi = yv[m][bj];
                    u32x4 w;
                    w.x = cvt_pk_bf16(gelu_tanh(v0[0] + bflo(yi.x)), gelu_tanh(v0[1] + bfhi(yi.x)));
                    w.y = cvt_pk_bf16(gelu_tanh(v0[2] + bflo(yi.y)), gelu_tanh(v0[3] + bfhi(yi.y)));
                    w.z = cvt_pk_bf16(gelu_tanh(v1[0] + bflo(yi.z)), gelu_tanh(v1[1] + bfhi(yi.z)));
                    w.w = cvt_pk_bf16(gelu_tanh(v1[2] + bflo(yi.w)), gelu_tanh(v1[3] + bfhi(yi.w)));
                    *(u32x4*)(Yi + ((size_t)(r * 32 + (c >> 4)) * DM + u.g * 16 + (c & 15))) = w; }
            asm volatile("" ::: "memory"); }
    }
};

struct EpiFfn {
    static constexpr bool PERM = true;
    bf16_t* G; float* halo; const float* cw; const float* cb; LAS float* edge; const float* ss; const float* bias;
    __device__ __forceinline__ void operator()(f32x4 (&acc)[2][2][4][2], const Unit& u, int wr, int wc, int fr, int fq) const {
        apply_rstd_bias(acc, ss, bias, u.pm * BM, u.pn * BM, true, wr, wc, fr, fq);
        asm volatile("" ::: "memory"); __builtin_amdgcn_sched_barrier(0);
        const int lane = fq * 16 + fr; const int cl = wc * 32 + 8 * fq;
        const int col0 = u.pn * HALF + cl;
        if (fr == 0) {
#pragma unroll
            for (int ai = 0; ai < 2; ++ai) { *(LAS f32x4*)(edge + ((wr * 2 + ai) * 2 + 0) * 128 + cl) = acc[ai][0][0][0]; *(LAS f32x4*)(edge + ((wr * 2 + ai) * 2 + 0) * 128 + cl + 4) = acc[ai][0][0][1]; } }
        if (fr == 15) {
#pragma unroll
            for (int ai = 0; ai < 2; ++ai) { *(LAS f32x4*)(edge + ((wr * 2 + ai) * 2 + 1) * 128 + cl) = acc[ai][0][3][0]; *(LAS f32x4*)(edge + ((wr * 2 + ai) * 2 + 1) * 128 + cl + 4) = acc[ai][0][3][1]; } }
        { float* hp = halo + (size_t)u.pm * 6 * DFF + col0;
          if (wr == 0 && fr < 2) { *(f32x4*)(hp + fr * DFF) = acc[0][0][0][0]; *(f32x4*)(hp + fr * DFF + 4) = acc[0][0][0][1]; if (fr == 0) { *(f32x4*)(hp + 4 * DFF) = acc[0][1][0][0]; *(f32x4*)(hp + 4 * DFF + 4) = acc[0][1][0][1]; } }
          if (wr == 1 && fr >= 14) { *(f32x4*)(hp + (fr - 12) * DFF) = acc[1][0][3][0]; *(f32x4*)(hp + (fr - 12) * DFF + 4) = acc[1][0][3][1]; if (fr == 15) { *(f32x4*)(hp + 5 * DFF) = acc[1][1][3][0]; *(f32x4*)(hp + 5 * DFF + 4) = acc[1][1][3][1]; } } }
        asm volatile("s_waitcnt lgkmcnt(0)" ::: "memory"); __builtin_amdgcn_s_barrier(); asm volatile("" ::: "memory");
        const int srcR = (lane & 48) | ((fr + 15) & 15), srcL = (lane & 48) | ((fr + 1) & 15);
        const int ow = wr ^ 1;
#pragma unroll
        for (int n = 0; n < 2; ++n) {
            const int cc = col0 + 4 * n;
            const f32x4 w0 = *(const f32x4*)(cw + cc), w1 = *(const f32x4*)(cw + DFF + cc), w2 = *(const f32x4*)(cw + 2 * DFF + cc), bb = *(const f32x4*)(cb + cc);
#pragma unroll
            for (int ai = 0; ai < 2; ++ai) {
                const int pa = (wr == 0) ? ai - 1 : ai, na = (wr == 0) ? ai : ai + 1;
                const f32x4 eP = (pa >= 0) ? *(const LAS f32x4*)(edge + ((ow * 2 + pa) * 2 + 1) * 128 + cl + 4 * n) : (f32x4){0.f, 0.f, 0.f, 0.f};
                const f32x4 eN = (na <= 1) ? *(const LAS f32x4*)(edge + ((ow * 2 + na) * 2 + 0) * 128 + cl + 4 * n) : (f32x4){0.f, 0.f, 0.f, 0.f};
                f32x4 Rprev = eP;
#pragma unroll
                for (int m = 0; m < 4; ++m) {
                    const int rt = ai * HALF + wr * 64 + m * 16 + fr;
                    f32x4 Rm, Ln; float o[4];
#pragma unroll
                    for (int e = 0; e < 4; ++e) { Rm[e] = dpp_rotr1(acc[ai][0][m][n][e]); Ln[e] = (m < 3) ? dpp_rotl1(acc[ai][0][m < 3 ? m + 1 : 3][n][e]) : eN[e]; }
#pragma unroll
                    for (int e = 0; e < 4; ++e) {
                        const float cur = acc[ai][0][m][n][e];
                        const float pv = dpp_shr1(Rprev[e], cur), nv = dpp_shl1(Ln[e], cur);
                        const float gt = pv * w0[e] + cur * w1[e] + nv * w2[e] + bb[e];
                        o[e] = gt * sigmoidf_(gt) * acc[ai][1][m][n][e]; }
                    if (rt != 0 && rt != 255) *(u32x2*)(G + (size_t)(u.pm * BM + rt) * DFF + cc) = (u32x2){cvt_pk_bf16(o[0], o[1]), cvt_pk_bf16(o[2], o[3])};
                    Rprev = Rm; asm volatile("" ::: "memory");
                }
            }
        }
    }
};

template <class Epi>
__device__ __forceinline__ void gemm_phase(LAS unsigned char* lds, const Gemm g, const Sched& S, const Epi& E) {
    const int tid = ltid(), wid = __builtin_amdgcn_readfirstlane(tid >> 6), lane = tid & 63, wr = wid >> 2, wc = wid & 3, fr = lane & 15, fq = lane >> 4;
    int nt = g.nt; asm volatile("" : "+s"(nt));
    unsigned voffA[2], voffB[2];
#pragma unroll
    for (int i = 0; i < 2; ++i) { int R, C; stage_rc(tid * 16 + i * 8192, R, C); const int Rb = Epi::PERM ? ((R & ~31) + perm32(R & 31)) : R;
        voffA[i] = (unsigned)(R * g.a_row + (C >> 4) * g.a_seg + (C & 15)) * 2u; voffB[i] = (unsigned)(Rb * g.ldb + C) * 2u; }
    const size_t kA = g.a_kstep, kB = (size_t)(BK * 2);
    const size_t hA = (size_t)HALF * g.a_row * 2, hB = (size_t)HALF * g.ldb * 2, tA = 2 * hA, tB = 2 * hB;
    const unsigned ldsw = (unsigned)wid * 1024u;
    const int aoff = lds_byte(wr * 64 + fr, fq * 8), boff = lds_byte(wc * 32 + fr, fq * 8);
#define PG8_SA(b, h) (((b) * 2 + (h)) * HTB)
#define PG8_SB(b, h) ((4 + (b) * 2 + (h)) * HTB)
#define PG8_STAGE(bufoff, gbase, voff) do { _Pragma("unroll") for (int _i = 0; _i < 2; ++_i) \
        __builtin_amdgcn_global_load_lds((const unsigned*)((const char*)(gbase) + (voff)[_i]), (LAS unsigned*)(lds + (bufoff) + ldsw + _i * 8192), 16, 0, 0); } while (0)
#define PG8_LDA(dst, b, h) do { _Pragma("unroll") for (int m = 0; m < 4; ++m) _Pragma("unroll") for (int k = 0; k < 2; ++k) dst[m][k] = *(const LAS bf16x8*)(lds + PG8_SA(b, h) + aoff + m * 2048 + k * 1024); } while (0)
#define PG8_LDB(dst, b, h) do { _Pragma("unroll") for (int n = 0; n < 2; ++n) _Pragma("unroll") for (int k = 0; k < 2; ++k) dst[n][k] = *(const LAS bf16x8*)(lds + PG8_SB(b, h) + boff + n * 2048 + k * 1024); } while (0)
#define PG8_MMA(ai, bj, At, Bt) do { __builtin_amdgcn_s_setprio(1); _Pragma("unroll") for (int m = 0; m < 4; ++m) _Pragma("unroll") for (int n = 0; n < 2; ++n) _Pragma("unroll") for (int k = 0; k < 2; ++k) \
        acc[ai][bj][m][n] = __builtin_amdgcn_mfma_f32_16x16x32_bf16(Bt[n][k], At[m][k], acc[ai][bj][m][n], 0, 0, 0); __builtin_amdgcn_s_setprio(0); } while (0)
#define PG8_WAIT_V(n) asm volatile("s_waitcnt vmcnt(" #n ")" ::: "memory")
#define PG8_WAIT_L(n) asm volatile("s_waitcnt lgkmcnt(" #n ")" ::: "memory")
#define PG8_BAR __builtin_amdgcn_s_barrier()
#define PG8_SCHED __builtin_amdgcn_sched_barrier(0)
    Unit cur, nxt; int ui = 0;
    if (!S.next(0, cur)) return;
    f32x4 acc[2][2][4][2];
#pragma unroll
    for (int a = 0; a < 2; ++a)
#pragma unroll
        for (int b = 0; b < 2; ++b)
#pragma unroll
            for (int m = 0; m < 4; ++m)
#pragma unroll
                for (int n = 0; n < 2; ++n) acc[a][b][m][n] = (f32x4){0.f, 0.f, 0.f, 0.f};
    bf16x8 At[4][2], B0[2][2], B1[2][2];
    const char* cA = g.A + (size_t)cur.g * g.a_g + (size_t)cur.pm * tA; const char* cB = g.B + (size_t)cur.g * g.b_g + (size_t)cur.pn * tB;
    PG8_STAGE(PG8_SB(0, 0), cB, voffB); PG8_STAGE(PG8_SB(0, 1), cB + hB, voffB); PG8_STAGE(PG8_SA(0, 0), cA, voffA); PG8_STAGE(PG8_SA(0, 1), cA + hA, voffA);
    if (wr == 1) PG8_BAR;
    PG8_WAIT_V(2); PG8_BAR;
    PG8_STAGE(PG8_SB(1, 0), cB + kB, voffB); PG8_STAGE(PG8_SA(1, 0), cA + kA, voffA); PG8_STAGE(PG8_SB(1, 1), cB + hB + kB, voffB);
    PG8_WAIT_V(6); PG8_BAR;
    for (;;) {
        const bool has_next = S.next(ui + 1, nxt);
        const char* nA = has_next ? g.A + (size_t)nxt.g * g.a_g + (size_t)nxt.pm * tA : cA; const char* nB = has_next ? g.B + (size_t)nxt.g * g.b_g + (size_t)nxt.pn * tB : cB;
        for (int t = 0; t < nt; t += 2) {
            const bool last = (t == nt - 2);
            const char* a1 = cA + (size_t)(t + 1) * kA;
            const char* a2 = last ? nA : cA + (size_t)(t + 2) * kA; const char* b2 = last ? nB : cB + (size_t)(t + 2) * kB;
            const char* a3 = a2 + kA; const char* b3 = b2 + kB;
            PG8_LDB(B0, 0, 0); PG8_LDB(B1, 0, 1); PG8_SCHED; PG8_LDA(At, 0, 0); PG8_STAGE(PG8_SA(1, 1), a1 + hA, voffA);
            PG8_WAIT_V(8); PG8_WAIT_L(0); PG8_BAR; PG8_MMA(0, 0, At, B0); PG8_MMA(0, 1, At, B1); PG8_BAR; PG8_SCHED;
            PG8_LDA(At, 0, 1); PG8_STAGE(PG8_SB(0, 0), b2, voffB); PG8_STAGE(PG8_SB(0, 1), b2 + hB, voffB); PG8_STAGE(PG8_SA(0, 0), a2, voffA);
            PG8_WAIT_V(8); PG8_WAIT_L(0); PG8_BAR; PG8_MMA(1, 0, At, B0); PG8_MMA(1, 1, At, B1); PG8_BAR; PG8_SCHED;
            PG8_LDB(B0, 1, 0); PG8_LDB(B1, 1, 1); PG8_SCHED; PG8_LDA(At, 1, 0); PG8_STAGE(PG8_SA(0, 1), a2 + hA, voffA);
            PG8_WAIT_V(8); PG8_WAIT_L(0); PG8_BAR; PG8_MMA(0, 0, At, B0); PG8_MMA(0, 1, At, B1); PG8_BAR; PG8_SCHED;
            PG8_LDA(At, 1, 1); PG8_STAGE(PG8_SB(1, 0), b3, voffB); PG8_STAGE(PG8_SB(1, 1), b3 + hB, voffB); PG8_STAGE(PG8_SA(1, 0), a3, voffA);
            PG8_WAIT_V(8); PG8_WAIT_L(0); PG8_BAR; PG8_MMA(1, 0, At, B0); PG8_MMA(1, 1, At, B1); PG8_BAR; PG8_SCHED;
        }
        if (wr == 0) PG8_BAR;
        E(acc, cur, wr, wc, fr, fq);
        if (!has_next) break;
#pragma unroll
        for (int a = 0; a < 2; ++a)
#pragma unroll
            for (int b = 0; b < 2; ++b)
#pragma unroll
                for (int m = 0; m < 4; ++m)
#pragma unroll
                    for (int n = 0; n < 2; ++n) acc[a][b][m][n] = (f32x4){0.f, 0.f, 0.f, 0.f};
        cur = nxt; cA = nA; cB = nB; ++ui;
        if (wr == 1) PG8_BAR;
    }
    PG8_WAIT_V(0);
    PG8_BAR;
#undef PG8_SA
#undef PG8_SB
#undef PG8_STAGE
#undef PG8_LDA
#undef PG8_LDB
#undef PG8_MMA
#undef PG8_WAIT_V
#undef PG8_WAIT_L
#undef PG8_BAR
#undef PG8_SCHED
}
}
namespace attn_body {
using bf16=__hip_bfloat16;
using bf16x8=__attribute__((ext_vector_type(8)))short;
using s16x4=__attribute__((ext_vector_type(4)))short;
using f32x16=__attribute__((ext_vector_type(16)))float;
using u32x4=__attribute__((ext_vector_type(4)))unsigned;
constexpr int BATCH=4,NHEAD=16,SEQ=8192,D=64,DM=NHEAD*D,DMK=256;
constexpr int NW=8,QBLK=32,QB=QBLK*NW,KVBLK=64,NQB=SEQ/QB;
constexpr int ATTN_PITCH=DM, ATTN_UNIT_ROWS=QB;
__device__ __forceinline__ int crow(int r,int hi){return (r&3)+8*(r>>2)+4*hi;}
#define SBAR() __builtin_amdgcn_sched_barrier(0)
__device__ __forceinline__ void cmask(f32x16&p0,f32x16&p1,int jb,int qrel,int hi){
  const float NEG=-INFINITY; int kb=64*jb+4*hi;
  #pragma unroll
  for(int r=0;r<16;++r){int kv=kb+(r&3)+8*(r>>2); if(kv>qrel)p0[r]=NEG; if(kv+32>qrel)p1[r]=NEG;}
}

constexpr int NSLOT=3, SLOTB=8192;
constexpr int LDS_K=0, LDS_V=NSLOT*SLOTB, LDS_WS=2*NSLOT*SLOTB, LDS_OST=LDS_WS+NW*64*4, LDS_BYTES=LDS_OST+NW*4096;
constexpr float C2=0.125f*1.4426950408889634f;
__device__ __forceinline__ void glds16(const void*gsrc,unsigned lds_dst){unsigned keep;
  asm volatile("s_mov_b32 %0, m0\n\ts_mov_b32 m0, %2\n\ts_nop 0\n\tglobal_load_lds_dwordx4 %1, off\n\ts_mov_b32 m0, %0":"=&s"(keep):"v"(gsrc),"s"(lds_dst):"memory");}
__device__ __forceinline__ float max3f(float a,float b,float c){float r;asm("v_max3_f32 %0, %1, %2, %3":"=v"(r):"v"(a),"v"(b),"v"(c));return r;}
__device__ __forceinline__ float max2f(float a,float b){float r;asm("v_max_f32_e32 %0, %1, %2":"=v"(r):"v"(a),"v"(b));return r;}
__device__ __forceinline__ float fadd_s(float a,float b){float r;asm("v_add_f32_e32 %0, %1, %2":"=v"(r):"v"(a),"v"(b));return r;}
__device__ __forceinline__ float fsub_s(float a,float b){float r;asm("v_sub_f32_e32 %0, %1, %2":"=v"(r):"v"(a),"v"(b));return r;}
typedef float f32x2_t __attribute__((ext_vector_type(2))); typedef __bf16 bf16x2_t __attribute__((ext_vector_type(2)));
__device__ __forceinline__ unsigned cvtpk_s(float lo,float hi){f32x2_t v={lo,hi};bf16x2_t b=__builtin_convertvector(v,bf16x2_t);return __builtin_bit_cast(unsigned,b);}
#define WAIT_BAR(N) asm volatile("s_waitcnt vmcnt(" #N ") lgkmcnt(0)\n\ts_barrier":::"memory")

__device__ __forceinline__ void qkt(f32x16&p0,f32x16&p1,const char*Kslot,const bf16x8*qr,const f32x16&negm,int r32,int hi){
  const char*kb=Kslot+hi*1024+r32*16;
  #pragma unroll
  for(int d0=0;d0<4;++d0){
    const bf16x8 b0=*reinterpret_cast<const bf16x8*>(kb+d0*2048);
    const bf16x8 b1=*reinterpret_cast<const bf16x8*>(kb+d0*2048+512);
    if(d0==0){p0=__builtin_amdgcn_mfma_f32_32x32x16_bf16(b0,qr[0],negm,0,0,0);p1=__builtin_amdgcn_mfma_f32_32x32x16_bf16(b1,qr[0],negm,0,0,0);}
    else{p0=__builtin_amdgcn_mfma_f32_32x32x16_bf16(b0,qr[d0],p0,0,0,0);p1=__builtin_amdgcn_mfma_f32_32x32x16_bf16(b1,qr[d0],p1,0,0,0);}}
}
typedef __attribute__((address_space(3))) const char* lds_cptr;
typedef short v4i16_t __attribute__((ext_vector_type(4)));
__device__ __forceinline__ void kload8(bf16x8*kf,lds_cptr kp){
  kf[0]=*(const __attribute__((address_space(3))) bf16x8*)(kp);      kf[1]=*(const __attribute__((address_space(3))) bf16x8*)(kp+512);
  kf[2]=*(const __attribute__((address_space(3))) bf16x8*)(kp+2048); kf[3]=*(const __attribute__((address_space(3))) bf16x8*)(kp+2560);
  kf[4]=*(const __attribute__((address_space(3))) bf16x8*)(kp+4096); kf[5]=*(const __attribute__((address_space(3))) bf16x8*)(kp+4608);
  kf[6]=*(const __attribute__((address_space(3))) bf16x8*)(kp+6144); kf[7]=*(const __attribute__((address_space(3))) bf16x8*)(kp+6656);
}
__device__ __forceinline__ void kload2(bf16x8*kf,lds_cptr kp,int j){ kf[2*j]=*(const __attribute__((address_space(3))) bf16x8*)(kp+j*2048); kf[2*j+1]=*(const __attribute__((address_space(3))) bf16x8*)(kp+j*2048+512); }
__device__ __forceinline__ s16x4 vtr(lds_cptr p){ return __builtin_bit_cast(s16x4,__builtin_amdgcn_ds_read_tr16_b64_v4i16((__attribute__((address_space(3))) v4i16_t*)p)); }
__device__ __forceinline__ float rowmax(const f32x16&p0,const f32x16&p1){
  float a=max3f(p0[0],p0[1],p1[0]),b=max3f(p0[2],p0[3],p1[1]);a=max3f(a,p1[2],p1[3]);
  #pragma unroll
  for(int r=4;r<16;r+=4){a=max3f(a,p0[r],p0[r+1]);b=max3f(b,p0[r+2],p0[r+3]);a=max3f(a,p1[r],p1[r+1]);b=max3f(b,p1[r+2],p1[r+3]);}
  const float m=max2f(a,b);
  auto rr=__builtin_amdgcn_permlane32_swap(__float_as_uint(m),__float_as_uint(m),false,false);
  return max2f(__uint_as_float(rr[0]),__uint_as_float(rr[1]));
}
__device__ __forceinline__ void pv(f32x16*o,int vb,bf16x8 pa0,bf16x8 pa1,bf16x8 pa2,bf16x8 pa3){
  #pragma unroll
  for(int d0=0;d0<2;++d0){s16x4 lo[4],hi[4];
    #pragma unroll
    for(int ks=0;ks<4;++ks){
      asm volatile("ds_read_b64_tr_b16 %0,%1 offset:%c2":"=&v"(lo[ks]):"v"(vb),"i"(d0*4096+ks*1024):"memory");
      asm volatile("ds_read_b64_tr_b16 %0,%1 offset:%c2":"=&v"(hi[ks]):"v"(vb),"i"(d0*4096+ks*1024+512):"memory");}
    asm volatile("s_waitcnt lgkmcnt(0)":::"memory");SBAR();
    #define PK(k) (bf16x8){lo[k][0],lo[k][1],lo[k][2],lo[k][3],hi[k][0],hi[k][1],hi[k][2],hi[k][3]}
    o[d0]=__builtin_amdgcn_mfma_f32_32x32x16_bf16(pa0,PK(0),o[d0],0,0,0);
    o[d0]=__builtin_amdgcn_mfma_f32_32x32x16_bf16(pa1,PK(1),o[d0],0,0,0);
    o[d0]=__builtin_amdgcn_mfma_f32_32x32x16_bf16(pa2,PK(2),o[d0],0,0,0);
    o[d0]=__builtin_amdgcn_mfma_f32_32x32x16_bf16(pa3,PK(3),o[d0],0,0,0);
    #undef PK
  }
}

#ifndef ATTN_STORE16
#define ATTN_STORE16(p,v) (*(u32x4*)(p)=(v))
#endif
template<int THRL> __device__ __forceinline__ void attn_unit(int b,int h,int qb,const bf16*Q,const bf16*__restrict__ K,const bf16*__restrict__ V,bf16*O,char*shm){
  const int tid=ltid(),lane=tid&63,r32=lane&31,hi=lane>>5; const int wid=__builtin_amdgcn_readfirstlane(tid>>6);
  const long rowbase=(long)b*SEQ; const int q0=qb*QB;
  const bf16*Qw=Q+(rowbase+q0+wid*QBLK)*DM+h*D;
  const bf16*Kh=K+rowbase*DMK+(h>>2)*D,*Vh=V+rowbase*DMK+(h>>2)*D;
  const unsigned lds0=(unsigned)(uintptr_t)shm;
  float*wsf=(float*)(shm+LDS_WS)+wid*64;
  const bf16*ksrc=Kh+(long)lane*DMK+wid*8;
  const bf16*vsrc=Vh+(long)(16*(wid&3)+(lane>>2))*DMK+(wid>>2)*32+(lane&3)*8;
  const unsigned kdst=lds0+LDS_K+wid*1024, vdst=lds0+LDS_V+wid*1024;
  #define DMA_K(t,slot) glds16(ksrc+(long)(t)*KVBLK*DMK,(unsigned)__builtin_amdgcn_readfirstlane(kdst+(slot)))
  #define DMA_V(t,slot) glds16(vsrc+(long)(t)*KVBLK*DMK,(unsigned)__builtin_amdgcn_readfirstlane(vdst+(slot)))
  const int vb0=(int)(lds0+LDS_V)+((lane>>4)&1)*32+(lane&3)*8+(4*hi+((lane&15)>>2))*64;
  const char*Kbase=shm+LDS_K; bf16x8 kf[8];
  const lds_cptr shm3=(lds_cptr)shm; const lds_cptr kp0=shm3+LDS_K+hi*1024+r32*16; const lds_cptr vp0=shm3+LDS_V+((lane>>4)&1)*32+(lane&3)*8+(4*hi+((lane&15)>>2))*64;
  const int NT=SEQ/KVBLK;
  DMA_K(0,0);DMA_V(0,0);DMA_K(1,SLOTB);
  bf16x8 qr[4];
  #pragma unroll
  for(int d0=0;d0<4;++d0)qr[d0]=*reinterpret_cast<const bf16x8*>(&Qw[(long)r32*DM+d0*16+hi*8]);
  float mhat=0.f,l_reg=0.f;f32x16 o[2];o[0]=f32x16{};o[1]=f32x16{};f32x16 negm=f32x16{};asm volatile("":"+v"(negm));
  const int qrel=wid*QBLK+r32;
  #define CMASK(P0,P1,t) do{}while(0)
  bool resc=false;
  #define START(P0,P1) do{ const float rm=rowmax(P0,P1); resc=false; \
    { const float dl=rm; mhat=fadd_s(mhat,dl); \
      _Pragma("unroll") for(int r=0;r<16;++r){P0[r]=fsub_s(P0[r],dl);P1[r]=fsub_s(P1[r],dl);} \
      _Pragma("unroll") for(int r=0;r<16;++r)negm[r]=-mhat; asm volatile("":"+v"(negm)); } \
    _Pragma("unroll") for(int r=0;r<16;++r)P0[r]=__builtin_amdgcn_exp2f(P0[r]); }while(0)
  #define RESC() do{ if(resc){ asm volatile("s_waitcnt lgkmcnt(0)":::"memory"); \
      _Pragma("unroll") for(int d_=0;d_<2;++d_) _Pragma("unroll") for(int r=0;r<16;++r)o[d_][r]*=wsf[crow(r,hi)]; } }while(0)
  f32x16 pA0,pA1,pB0,pB1;
  int sl_prev=0,sl_cur=0,sl_next=SLOTB;
  #define ROT() do{sl_prev=sl_cur;sl_cur=sl_next;sl_next=(sl_next==(NSLOT-1)*SLOTB)?0:sl_next+SLOTB;}while(0)
  DMA_K(2,2*SLOTB);
  WAIT_BAR(3);
  qkt(pA0,pA1,Kbase,qr,negm,r32,hi);asm volatile("s_nop 15\n\ts_nop 7":"+v"(pA0),"+v"(pA1));CMASK(pA0,pA1,0);
  START(pA0,pA1);
  _Pragma("unroll") for(int r=0;r<16;++r)pA1[r]=__builtin_amdgcn_exp2f(pA1[r]);
  WAIT_BAR(0);
  DMA_K(3,0);DMA_V(1,SLOTB);
  ROT();
  kload8(kf,kp0+sl_cur);
  WAIT_BAR(2);
  s16x4 vlo[8],vhi[8]; u32x4 pw0,pw1,pw2,pw3;
  #define PKW(P,B) cvtpk_s(P[B],P[B+1])
  #define PAF(k) __builtin_bit_cast(bf16x8,pw##k)
  #define VFR(i) (bf16x8){vlo[i][0],vlo[i][1],vlo[i][2],vlo[i][3],vhi[i][0],vhi[i][1],vhi[i][2],vhi[i][3]}
  #define PIN(x) asm volatile("":"+v"(x))
  #define MX3(a,b,c) __builtin_fmaxf(__builtin_fmaxf((a),(b)),(c))
  #define GAPA(MF,A0,A1,A2,A3,W0,W1,PW) do{ MF; sacc+=A0; sacc+=A1; sacc+=A2; sacc+=A3; PIN(sacc); W0; W1; PIN(PW); SBAR(); }while(0)
  #define EX(v) __builtin_amdgcn_exp2f(v)
  #define GAPB(MF,X,B) do{ MF; X[B]=EX(X[B]); X[B+1]=EX(X[B+1]); X[B+2]=EX(X[B+2]); X[B+3]=EX(X[B+3]); PIN(X); SBAR(); }while(0)
  #define VRD(i) do{ vlo[i]=vtr(vp_+(((i)>>2)*4096+((i)&3)*1024)); vhi[i]=vtr(vp_+(((i)>>2)*4096+((i)&3)*1024+512)); }while(0)
  #define KRD(G,j) do{ if(G){ kload2(kf,kp0+sl_next,j); SBAR(); } }while(0)
  #define STEP(C0,C1,P0,P1,t,GK,GV,GL) do{ SBAR(); \
    const lds_cptr vp_=vp0+sl_prev; \
    VRD(0); SBAR(); float sacc=(P0[0]+P0[1]); \
    GAPA(C0=__builtin_amdgcn_mfma_f32_32x32x16_bf16(kf[0],qr[0],negm,0,0,0), P0[2],P0[3],P0[4],P0[5],     pw0[0]=PKW(P0,0), pw0[1]=PKW(P0,2), pw0); \
    VRD(4); SBAR(); GAPA(C1=__builtin_amdgcn_mfma_f32_32x32x16_bf16(kf[1],qr[0],negm,0,0,0), P0[6],P0[7],P0[8],P0[9],     pw0[2]=PKW(P0,4), pw0[3]=PKW(P0,6), pw0); \
    VRD(1); SBAR(); GAPA(C0=__builtin_amdgcn_mfma_f32_32x32x16_bf16(kf[2],qr[1],C0,0,0,0),   P0[10],P0[11],P0[12],P0[13], pw1[0]=PKW(P0,8), pw1[1]=PKW(P0,10), pw1); \
    VRD(5); SBAR(); GAPA(C1=__builtin_amdgcn_mfma_f32_32x32x16_bf16(kf[3],qr[1],C1,0,0,0),   P0[14],P0[15],P1[0],P1[1],   pw1[2]=PKW(P0,12),pw1[3]=PKW(P0,14), pw1); \
    VRD(2); SBAR(); GAPA(C0=__builtin_amdgcn_mfma_f32_32x32x16_bf16(kf[4],qr[2],C0,0,0,0),   P1[2],P1[3],P1[4],P1[5],     pw2[0]=PKW(P1,0), pw2[1]=PKW(P1,2), pw2); \
    VRD(6); SBAR(); GAPA(C1=__builtin_amdgcn_mfma_f32_32x32x16_bf16(kf[5],qr[2],C1,0,0,0),   P1[6],P1[7],P1[8],P1[9],     pw2[2]=PKW(P1,4), pw2[3]=PKW(P1,6), pw2); \
    VRD(3); SBAR(); GAPA(C0=__builtin_amdgcn_mfma_f32_32x32x16_bf16(kf[6],qr[3],C0,0,0,0),   P1[10],P1[11],P1[12],P1[13], pw3[0]=PKW(P1,8), pw3[1]=PKW(P1,10), pw3); \
    VRD(7); SBAR(); GAPA(C1=__builtin_amdgcn_mfma_f32_32x32x16_bf16(kf[7],qr[3],C1,0,0,0),   P1[14],P1[15],0.f,0.f,       pw3[2]=PKW(P1,12),pw3[3]=PKW(P1,14), pw3); \
    l_reg+=sacc; \
    if(GK){DMA_K((t)+3,sl_cur);} if(GV){DMA_V((t)+1,sl_next);} \
    CMASK(C0,C1,t); \
    { float a=MX3(C0[0],C0[1],C1[0]),b=MX3(C0[2],C0[3],C1[1]); a=MX3(a,C1[2],C1[3]); \
      _Pragma("unroll") for(int r=4;r<16;r+=4){a=MX3(a,C0[r],C0[r+1]);b=MX3(b,C0[r+2],C0[r+3]);a=MX3(a,C1[r],C1[r+1]);b=MX3(b,C1[r+2],C1[r+3]);} \
      float rm=__builtin_fmaxf(a,b); { auto rr=__builtin_amdgcn_permlane32_swap(__float_as_uint(rm),__float_as_uint(rm),false,false); rm=__builtin_fmaxf(__uint_as_float(rr[0]),__uint_as_float(rr[1])); } \
      resc=false; \
      if(__builtin_expect(__any(rm>(float)THRL),0)){ const float dl=__builtin_fmaxf(rm,0.f); mhat+=dl; \
        _Pragma("unroll") for(int r=0;r<16;++r){C0[r]-=dl;C1[r]-=dl;} \
        _Pragma("unroll") for(int r=0;r<16;++r)negm[r]=-mhat; asm volatile("":"+v"(negm)); \
        const float f=__builtin_amdgcn_exp2f(-dl); l_reg*=f; if(hi==0)wsf[r32]=f; resc=true; } } \
    SBAR(); \
    GAPB(o[0]=__builtin_amdgcn_mfma_f32_32x32x16_bf16(PAF(0),VFR(0),o[0],0,0,0), C0,0); \
    GAPB(o[1]=__builtin_amdgcn_mfma_f32_32x32x16_bf16(PAF(0),VFR(4),o[1],0,0,0), C0,4); \
    KRD(GL,0); GAPB(o[0]=__builtin_amdgcn_mfma_f32_32x32x16_bf16(PAF(1),VFR(1),o[0],0,0,0), C0,8); \
    KRD(GL,1); GAPB(o[1]=__builtin_amdgcn_mfma_f32_32x32x16_bf16(PAF(1),VFR(5),o[1],0,0,0), C0,12); \
    KRD(GL,2); GAPB(o[0]=__builtin_amdgcn_mfma_f32_32x32x16_bf16(PAF(2),VFR(2),o[0],0,0,0), C1,0); \
    KRD(GL,3); GAPB(o[1]=__builtin_amdgcn_mfma_f32_32x32x16_bf16(PAF(2),VFR(6),o[1],0,0,0), C1,4); \
    GAPB(o[0]=__builtin_amdgcn_mfma_f32_32x32x16_bf16(PAF(3),VFR(3),o[0],0,0,0), C1,8); \
    GAPB(o[1]=__builtin_amdgcn_mfma_f32_32x32x16_bf16(PAF(3),VFR(7),o[1],0,0,0), C1,12); \
    }while(0)
  int t=1;
  #undef CMASK
  #define CMASK(P0,P1,t) do{}while(0)
  for(;t+5<NT;t+=2){
    STEP(pB0,pB1,pA0,pA1,t,true,true,true);     WAIT_BAR(2); RESC(); ROT();
    STEP(pA0,pA1,pB0,pB1,t+1,true,true,true);   WAIT_BAR(2); RESC(); ROT();
  }
  #undef CMASK
  #define CMASK(P0,P1,t) do{}while(0)
  #define ENDW(tt) do{ if((tt)+3<NT){WAIT_BAR(2);} else if((tt)+2<NT){WAIT_BAR(1);} else {WAIT_BAR(0);} }while(0)
  for(;t+1<NT;t+=2){
    STEP(pB0,pB1,pA0,pA1,t,(t+3<NT),(t+1<NT),(t+1<NT));       ENDW(t);   RESC(); ROT();
    STEP(pA0,pA1,pB0,pB1,t+1,(t+4<NT),(t+2<NT),(t+2<NT));     ENDW(t+1); RESC(); ROT();
  }
  STEP(pB0,pB1,pA0,pA1,NT-1,false,false,false); RESC();
  { float sacc=pB0[0]+pB0[1]; _Pragma("unroll") for(int r=2;r<16;++r)sacc+=pB0[r]; _Pragma("unroll") for(int r=0;r<16;++r)sacc+=pB1[r]; l_reg+=sacc;
    pw0=(u32x4){PKW(pB0,0),PKW(pB0,2),PKW(pB0,4),PKW(pB0,6)};pw1=(u32x4){PKW(pB0,8),PKW(pB0,10),PKW(pB0,12),PKW(pB0,14)};pw2=(u32x4){PKW(pB1,0),PKW(pB1,2),PKW(pB1,4),PKW(pB1,6)};pw3=(u32x4){PKW(pB1,8),PKW(pB1,10),PKW(pB1,12),PKW(pB1,14)};
    SBAR(); pv(o,vb0+sl_cur,PAF(0),PAF(1),PAF(2),PAF(3)); }
  #undef PKW
  #undef PAF
  #undef VFR
  #undef PIN
  #undef MX3
  #undef GAPA
  #undef GAPB
  #undef EX
  #undef VRD
  #undef KRD
  #undef STEP
  #undef ENDW
  {auto rr=__builtin_amdgcn_permlane32_swap(__float_as_uint(l_reg),__float_as_uint(l_reg),false,false);l_reg=__uint_as_float(rr[0])+__uint_as_float(rr[1]);}
  if(hi==0)wsf[32+r32]=l_reg;asm volatile("s_waitcnt lgkmcnt(0)":::"memory");
  float rli[16];
  #pragma unroll
  for(int r=0;r<16;++r)rli[r]=__builtin_amdgcn_rcpf(wsf[32+crow(r,hi)]);
  bf16*Ow=O+(rowbase+q0+wid*QBLK)*DM+h*D;
  { bf16*stg=(bf16*)(shm+LDS_OST)+wid*2048;
    #pragma unroll
    for(int r=0;r<16;++r){const int orow=crow(r,hi);
      #pragma unroll
      for(int d0=0;d0<2;++d0)stg[orow*64+d0*32+r32]=__float2bfloat16(o[d0][r]*rli[r]);}
    asm volatile("s_waitcnt lgkmcnt(0)":::"memory");
    #pragma unroll
    for(int i=0;i<4;++i){const int row=i*8+(lane>>3),ch=lane&7; const u32x4 v=*(const u32x4*)(stg+row*64+ch*8); ATTN_STORE16(Ow+(long)row*DM+ch*8,v);} }
  asm volatile("s_waitcnt lgkmcnt(0)\n\ts_barrier":::"memory");
  #undef DMA_K
  #undef DMA_V
  #undef CMASK
  #undef START
  #undef RESC
  #undef ROT
}
constexpr int ATTN_LDS_BYTES=LDS_BYTES;
struct AttnTensors { const bf16* Q; const bf16* K; const bf16* V; bf16* O; };
struct AttnUnit { int bh; int qb; };
struct StaticOrder {
  int vcu, G, bid;
  __device__ __forceinline__ explicit StaticOrder(int grid,int block):vcu((grid%8==0)?(block%8)*(grid/8)+block/8:block),G(grid),bid(block){}
  __device__ __forceinline__ bool next(int i,AttnUnit&u)const{
    if(G==256){ if(i>=8)return false; const int xcd=vcu>>5,c=vcu&31,kvg=xcd+8*(i>>2);
      u.bh=(kvg>>2)*16+(kvg&3)*4+(c>>3); u.qb=(c&7)*4+(i&3); return true; }
    const int id=i*G+bid; if(id>=BATCH*NHEAD*NQB)return false; u.bh=id/NQB; u.qb=id%NQB; return true; }
  __device__ __forceinline__ void a_ready(const AttnUnit&)const{}
  __device__ __forceinline__ void done(const AttnUnit&)const{}
};
template<class Sched,int THRL=8> __device__ __forceinline__ void attn_phase(char*lds,const AttnTensors&T,const Sched&S){
  AttnUnit u;
  for(int i=0;S.next(i,u);++i){ S.a_ready(u); attn_unit<THRL>(u.bh/NHEAD,u.bh%NHEAD,u.qb,T.Q,T.K,T.V,T.O,lds); S.done(u); }
}
#undef SBAR
#undef WAIT_BAR
}

constexpr size_t MiB = 1u << 20;
constexpr size_t WS_MODP = 1 * MiB;
constexpr size_t WS_MOD  = 4 * MiB;
constexpr size_t WS_A2   = 5 * MiB;
constexpr size_t WS_LP   = 7 * MiB + 512 * 1024;
constexpr size_t WS_BBAR = 10 * MiB;
constexpr size_t WS_KTAB = 11 * MiB;
constexpr size_t WS_SS   = 15 * MiB;
constexpr size_t WS_BIAS = 1 * MiB;
constexpr size_t R_H2 = 168 * MiB + 192 * MiB;
constexpr size_t WS_ROPE = 2 * MiB;
constexpr size_t WS_BAR  = 4 * MiB + 384 * 1024;
constexpr size_t WS_W    = 16 * MiB;
constexpr size_t WS_H    = 104 * MiB;
constexpr size_t WS_R    = 168 * MiB;
constexpr size_t WS_END  = 512 * MiB;
constexpr size_t WO_UP(int i) { return (size_t)i * 8650752; }
constexpr size_t WO_DN(int i) { return (size_t)i * 8650752 + 5767168; }
constexpr size_t WO_QKV(int j) { return 34603008 + (size_t)j * 2621440; }
constexpr size_t WO_WO(int j) { return 34603008 + (size_t)j * 2621440 + 1572864; }
constexpr size_t WO_HIN = 39845888, WO_HOUT = 39845888 + 3145728, WO_GLU = 44040192;
constexpr size_t R_QKV = WS_R, R_QN = WS_R + 96 * MiB, R_KN = WS_R + 160 * MiB, R_VC = WS_R + 176 * MiB;
constexpr size_t R_G = WS_R, R_HALO = WS_R + 176 * MiB;
constexpr size_t R_UPRE = WS_R, R_X1 = WS_R + 192 * MiB, R_X2 = WS_R + 256 * MiB;
constexpr size_t R_Z1S = WS_R + 192 * MiB, R_KFS = WS_R + 224 * MiB, R_Z2 = WS_H, R_Z2T = WS_R;
constexpr size_t R_BT1 = WS_R, R_CM = WS_R + 48 * MiB, R_YI = WS_R + 64 * MiB, R_S = WS_R + 128 * MiB, R_XC = WS_R + 192 * MiB;

constexpr int RING_BYTES = 131072, MISC_OFF = RING_BYTES, LDS_BYTES = 147456;

struct Args { const float* in[35]; float* out; unsigned char* ws; int ph_lo, ph_hi; unsigned char prog[96][4]; };
enum Kind { K_PRO = 0, K_MODRED, K_NORMMOD, K_GEMM_QKV, K_QKN, K_ATT, K_GEMM_WO, K_GEMM_UP, K_FFNCONV, K_GEMM_DN, K_GEMM_HIN, K_HCT, K_HFFT, K_HTR, K_GEMM_HOUT,
            K_S5PREP, K_GEMM_S1, K_S5SCAN, K_GEMM_S2, K_GEMM_GLU, K_FINAL };

struct Ctx { LAS unsigned char* lds; int tid, lane, wave, G, vcu, gw, NGW, bid; };

__device__ __forceinline__ void transpose_item(const float* W, int K, int N, bf16_t* WT, int mode, LAS float* scr, int item, int lane) {
    const int nblk = N / 32, kb = item / nblk, nb = item % nblk, k0 = 64 * kb, n0 = 32 * nb;
    float tv[32];
#pragma unroll
    for (int i = 0; i < 32; ++i) tv[i] = W[(size_t)(k0 + 2 * i + (lane >> 5)) * N + n0 + (lane & 31)];
#pragma unroll
    for (int i = 0; i < 32; ++i) scr[(2 * i + (lane >> 5)) * 33 + (lane & 31)] = tv[i];
    asm volatile("s_waitcnt lgkmcnt(0)" ::: "memory");
    int r0 = n0;
    if (mode == 1) { const int half = n0 >> 10, c = n0 & 1023; r0 = 256 * (c >> 7) + 128 * half + (c & 127); }
    if (mode == 2) { const int half = n0 / DFF, c = n0 - half * DFF; r0 = 256 * (c >> 7) + 128 * half + (c & 127); }
    const int c = lane & 7;
#pragma unroll
    for (int j = 0; j < 4; ++j) { const int n = (lane >> 3) + 8 * j; const LAS float* s = scr + (8 * c) * 33 + n;
        u32x4 o; o.x = pk2(s[0 * 33], s[1 * 33]); o.y = pk2(s[2 * 33], s[3 * 33]); o.z = pk2(s[4 * 33], s[5 * 33]); o.w = pk2(s[6 * 33], s[7 * 33]);
        *(u32x4*)(WT + (size_t)(r0 + n) * K + k0 + 8 * c) = o; }
    asm volatile("s_waitcnt lgkmcnt(0)" ::: "memory");
}

__device__ __forceinline__ void phase_prologue(const Ctx& F, const Args& a) {
    bf16_t* Wb = (bf16_t*)(a.ws + WS_W);
    LAS float* scr = (LAS float*)(F.lds + F.wave * 16384);
    for (int it = F.gw; it < 22528; it += F.NGW) {
        int r = it; const float* src; int K, N, mode = 0; size_t dsto;
        if (r < 4 * 4224) { const int i = r / 4224; r -= i * 4224;
            if (r < 2816) { src = a.in[31] + (size_t)i * 1024 * 5632; K = 1024; N = 5632; dsto = WO_UP(i); mode = 2; }
            else { r -= 2816; src = a.in[34] + (size_t)i * 2816 * 1024; K = 2816; N = 1024; dsto = WO_DN(i); } }
        else { r -= 4 * 4224;
            if (r < 2 * 1280) { const int j = r / 1280; r -= j * 1280;
                if (r < 768) { src = a.in[7] + (size_t)j * 1024 * 1536; K = 1024; N = 1536; dsto = WO_QKV(j); }
                else { r -= 768; src = a.in[8] + (size_t)j * 1024 * 1024; K = 1024; N = 1024; dsto = WO_WO(j); } }
            else { r -= 2 * 1280;
                if (r < 1536) { src = a.in[11]; K = 1024; N = 3072; dsto = WO_HIN; }
                else if (r < 2048) { r -= 1536; src = a.in[21]; K = 1024; N = 1024; dsto = WO_HOUT; }
                else { r -= 2048; src = a.in[30]; K = 1024; N = 2048; dsto = WO_GLU; mode = 1; } } }
        transpose_item(src, K, N, Wb + dsto, mode, scr, r, F.lane);
    }
    { f32x4* SS = (f32x4*)(a.ws + WS_SS); const float one = (1.0f - EPS) * (float)DM;
      for (int i = F.gw * 64 + F.lane; i < 8 * TOK / 4; i += F.NGW * 64) SS[i] = (i < TOK / 4) ? (f32x4){one, one, one, one} : (f32x4){0.f, 0.f, 0.f, 0.f}; }
    {
        const float* c = a.in[1]; const float* aw = a.in[2]; float* modp = (float*)(a.ws + WS_MODP);
        for (int it = F.gw; it < 768; it += F.NGW) {
            const int kc = it & 7, nb = (it >> 3) % 24, i = it / 192;
            f32x4 acc[4]; for (int b = 0; b < 4; ++b) acc[b] = (f32x4){0.f, 0.f, 0.f, 0.f};
            const float* wp = aw + ((size_t)i * 1024 + kc * 128) * 6144 + nb * 256 + F.lane * 4;
#pragma unroll 1
            for (int k0 = 0; k0 < 128; k0 += 16) { f32x4 wv[16];
#pragma unroll
                for (int k = 0; k < 16; ++k) wv[k] = *(const f32x4*)(wp + (size_t)(k0 + k) * 6144);
#pragma unroll
                for (int k = 0; k < 16; ++k)
#pragma unroll
                    for (int b = 0; b < 4; ++b) { const float cv = c[b * 1024 + kc * 128 + k0 + k]; const float ca = cv * sigmoidf_(cv); acc[b] = acc[b] + wv[k] * ca; } }
            { float* modo = (float*)(a.ws + WS_MOD); const f32x4 bia = (kc == 0) ? *(const f32x4*)(a.in[3] + (size_t)i * 6144 + nb * 256 + F.lane * 4) : (f32x4){0.f, 0.f, 0.f, 0.f};
#pragma unroll
              for (int b = 0; b < 4; ++b) { float* mp = modo + ((size_t)i * 4 + b) * 6144 + nb * 256 + F.lane * 4;
#pragma unroll
                  for (int e = 0; e < 4; ++e) atomicAdd(mp + e, acc[b][e] + bia[e]); } }
        }
    }
    {
        const float *w1 = a.in[14], *b1 = a.in[15], *w2 = a.in[16], *b2 = a.in[17], *fq = a.in[19]; float* A2 = (float*)(a.ws + WS_A2);
        const int j = F.lane; const float fj = fq[j], b1j = b1[j], b2j = b2[j];
        for (int it = F.gw; it < SEQ / 4; it += F.NGW) {
            const int t0 = it * 4;
            for (int tt = 0; tt < 4; ++tt) {
                const int t = t0 + tt;
                const float tl = (float)t * (1.0f / (float)(SEQ - 1));
                const float w = 6.283185307179586f * (float)t / (float)SEQ;
                float s = tl * w1[j] + b1j;
#pragma unroll
                for (int k = 0; k < 16; ++k) { const float f = 1e-4f + (float)k * ((15.0f - 1e-4f) / 15.0f); const float ang = w * f;
                    s += cosf(ang) * w1[(1 + k) * 64 + j]; s += -sinf(ang) * w1[(17 + k) * 64 + j]; }
                const float a1 = sinf(fj * s);
                float s2 = b2j;
                for (int i = 0; i < 64; ++i) s2 += bperm(a1, i) * w2[i * 64 + j];
                scr[j * 5 + tt] = sinf(fj * s2);
            }
            asm volatile("s_waitcnt lgkmcnt(0)" ::: "memory");
#pragma unroll
            for (int r = 0; r < 4; ++r) { const int idx = r * 64 + F.lane, jj = idx >> 2, tt = idx & 3; A2[(size_t)jj * (SEQ + 64) + t0 + tt] = scr[jj * 5 + tt]; }
            asm volatile("s_waitcnt lgkmcnt(0)" ::: "memory");
        }
    }
    {
        const float *Are = a.in[22], *Aim = a.in[23], *ldt = a.in[24], *Bre = a.in[25], *Bim = a.in[26];
        f32x2* LP = (f32x2*)(a.ws + WS_LP); f32x2* BB = (f32x2*)(a.ws + WS_BBAR);
        for (int it = F.gw; it < 128; it += F.NGW) {
            const int g = it >> 1, dir = it & 1, p = F.lane;
            const float lre = fminf(Are[(dir * 64 + g) * 64 + p], -1e-4f), lim = Aim[(dir * 64 + g) * 64 + p]; const float dt = expf(ldt[dir * 64 + g]);
            for (int n = 0; n <= 32; ++n) { const float mg = expf((float)n * lre * dt), an = (float)n * lim * dt; LP[((size_t)(g * 2 + dir) * 33 + n) * 64 + p] = (f32x2){mg * cosf(an), mg * sinf(an)}; }
            const float mg = expf(lre * dt), an = lim * dt; const float nr = mg * cosf(an) - 1.0f, ni = mg * sinf(an);
            const float den = lre * lre + lim * lim; const float cr = (nr * lre + ni * lim) / den, ci = (ni * lre - nr * lim) / den;
            for (int h = 0; h < 16; ++h) { const size_t bi = ((size_t)(dir * 64 + g) * 64 + p) * 16 + h; const float br = Bre[bi], bm = Bim[bi];
                BB[((size_t)(g * 2 + dir) * 64 + p) * 16 + h] = (f32x2){cr * br - ci * bm, cr * bm + ci * br}; }
        }
    }
}

__device__ __forceinline__ void phase_modred(const Ctx& F, const Args& a) {
    const float *Cre = a.in[27], *Cim = a.in[28]; const f32x2* LP = (const f32x2*)(a.ws + WS_LP); const f32x2* BB = (const f32x2*)(a.ws + WS_BBAR); float* KT = (float*)(a.ws + WS_KTAB);
    for (int it = F.gw; it < 64 * 2 * 32; it += F.NGW) {
        const int tau = it & 31, dir = (it >> 5) & 1, g = it >> 6; const int gd = g * 2 + dir;
        const int ho = F.lane >> 2, hi0 = 4 * (F.lane & 3); float acc[4] = {0.f, 0.f, 0.f, 0.f};
#pragma unroll 1
        for (int p0 = 0; p0 < 64; p0 += 8) {
            f32x2 lv[8]; float crv[8], cmv[8]; f32x4 bv[8][2];
#pragma unroll
            for (int k = 0; k < 8; ++k) { const int p = p0 + k; lv[k] = LP[((size_t)gd * 33 + tau) * 64 + p]; const size_t ci = ((size_t)(dir * 64 + g) * 16 + ho) * 64 + p; crv[k] = Cre[ci]; cmv[k] = Cim[ci];
                const f32x4* bp = (const f32x4*)(BB + ((size_t)gd * 64 + p) * 16 + hi0); bv[k][0] = bp[0]; bv[k][1] = bp[1]; }
#pragma unroll
            for (int k = 0; k < 8; ++k) { const float er = crv[k] * lv[k].x - cmv[k] * lv[k].y, ei = crv[k] * lv[k].y + cmv[k] * lv[k].x;
                acc[0] += er * bv[k][0].x - ei * bv[k][0].y; acc[1] += er * bv[k][0].z - ei * bv[k][0].w; acc[2] += er * bv[k][1].x - ei * bv[k][1].y; acc[3] += er * bv[k][1].z - ei * bv[k][1].w; }
        }
        *(f32x4*)(KT + (((size_t)gd * 32 + tau) * 16 + ho) * 16 + hi0) = (f32x4){acc[0], acc[1], acc[2], acc[3]};
    }
}

__device__ __forceinline__ void phase_normmod(const Ctx& F, const Args& a, int layer, int which) {
    const bool first = (layer == 0 && which == 0);
    const float* src = first ? a.in[0] : a.out; float* X = a.out; bf16_t* H = (bf16_t*)(a.ws + WS_H);
    const float* gn = (which ? a.in[5] : a.in[4]) + layer * 1024; const float* mod = (const float*)(a.ws + WS_MOD) + (size_t)layer * 4 * 6144 + which * 3072;
    const int rows_per = TOK / F.NGW;
    const int r0 = F.gw * rows_per, b = r0 / SEQ;
    f32x4 cs[4], sh[4];
#pragma unroll
    for (int j = 0; j < 4; ++j) { const int c = (F.lane + 64 * j) * 4; const f32x4 g = *(const f32x4*)(gn + c), sc = *(const f32x4*)(mod + (size_t)b * 6144 + 1024 + c); sh[j] = *(const f32x4*)(mod + (size_t)b * 6144 + c); cs[j] = g * (sc + 1.0f); }
#pragma unroll 1
    for (int r = r0; r < r0 + rows_per; r += 4) {
        f32x4 v[4][4];
#pragma unroll
        for (int q = 0; q < 4; ++q) { const f32x4* xr = (const f32x4*)(src + (size_t)(r + q) * DM) + F.lane;
#pragma unroll
            for (int j = 0; j < 4; ++j) v[q][j] = xr[64 * j]; }
#pragma unroll
        for (int q = 0; q < 4; ++q) { float s = 0.f;
#pragma unroll
            for (int j = 0; j < 4; ++j) s += (v[q][j].x * v[q][j].x + v[q][j].y * v[q][j].y) + (v[q][j].z * v[q][j].z + v[q][j].w * v[q][j].w);
            const float rstd = 1.0f / sqrtf(wave_sum(s, F.lane) * (1.0f / DM) + EPS);
            u32x2* o8 = (u32x2*)(H + (size_t)(r + q) * DM) + F.lane;
#pragma unroll
            for (int j = 0; j < 4; ++j) { const f32x4 y = v[q][j] * rstd * cs[j] + sh[j]; o8[64 * j] = (u32x2){pk2(y.x, y.y), pk2(y.z, y.w)}; }
            }
    }
}
__device__ __forceinline__ void phase_bias(const Ctx& F, const Args& a) {
    const bf16_t* Wb = (const bf16_t*)(a.ws + WS_W); const float* mod = (const float*)(a.ws + WS_MOD); float* bias = (float*)(a.ws + WS_BIAS);
    const int per = (pg8::NBIAS + F.NGW - 1) / F.NGW; const int r0 = F.gw * per, r1 = (r0 + per < pg8::NBIAS) ? r0 + per : pg8::NBIAS;
    {
        f32x2* rope = (f32x2*)(a.ws + WS_ROPE); const int pi = F.lane & 31; const float inv = 1.0f / powf(10000.0f, (float)(pi & 15) / 16.0f);
        for (int it = F.gw; it < SEQ / 2; it += F.NGW) { const int t = it * 2 + (F.lane >> 5); const float pos = (pi < 16) ? (float)(t >> 6) : (float)(t & 63); const float ang = pos * inv;
            rope[(size_t)t * 32 + pi] = (f32x2){cosf(ang), sinf(ang)}; }
    }
    int cur = -1; f32x4 sh[4][4];
    auto rowptr = [&](int row, int& cons, int& layer, int& which) -> const bf16_t* {
        if (row < 22528) { layer = row / 5632; which = 1; cons = layer; return Wb + WO_UP(layer) + (size_t)(row - layer * 5632) * 1024; }
        if (row < 25600) { layer = 1; which = 0; cons = 4; return Wb + WO_HIN + (size_t)(row - 22528) * 1024; }
        layer = 3; which = 0; cons = 5; return Wb + WO_QKV(1) + (size_t)(row - 25600) * 1024; };
#pragma unroll 1
    for (int rb = r0; rb < r1; rb += 4) {
        u32x4 wv[4][2];
#pragma unroll
        for (int k = 0; k < 4; ++k) { const int row = (rb + k < r1) ? rb + k : r1 - 1; int c_, l_, w_; const bf16_t* wrow = rowptr(row, c_, l_, w_); wv[k][0] = *(const u32x4*)(wrow + F.lane * 16); wv[k][1] = *(const u32x4*)(wrow + F.lane * 16 + 8); }
#pragma unroll
        for (int k = 0; k < 4; ++k) { const int row = rb + k; if (row >= r1) break;
            int cons, layer, which; (void)rowptr(row, cons, layer, which);
            if (cons != cur) { cur = cons;
#pragma unroll
                for (int b = 0; b < 4; ++b)
#pragma unroll
                    for (int q = 0; q < 4; ++q) sh[b][q] = *(const f32x4*)(mod + ((size_t)layer * 4 + b) * 6144 + which * 3072 + F.lane * 16 + 4 * q); }
            float wf[16];
#pragma unroll
            for (int e = 0; e < 4; ++e) { wf[2 * e] = bflo(wv[k][0][e]); wf[2 * e + 1] = bfhi(wv[k][0][e]); wf[8 + 2 * e] = bflo(wv[k][1][e]); wf[9 + 2 * e] = bfhi(wv[k][1][e]); }
#pragma unroll
            for (int b = 0; b < 4; ++b) { float d = 0.f;
#pragma unroll
                for (int q = 0; q < 4; ++q) d += (sh[b][q].x * wf[4 * q] + sh[b][q].y * wf[4 * q + 1]) + (sh[b][q].z * wf[4 * q + 2] + sh[b][q].w * wf[4 * q + 3]);
                d = wave_sum(d, F.lane); if (F.lane == 0) bias[(size_t)b * pg8::NBIAS + row] = d; }
        }
    }
}
__device__ __forceinline__ void phase_final(const Ctx& F, const Args& a) {
    float* X = a.out; const float* gn = a.in[6];
    f32x4 g[4];
#pragma unroll
    for (int j = 0; j < 4; ++j) g[j] = *(const f32x4*)(gn + (F.lane + 64 * j) * 4);
    const int rows_per = TOK / F.NGW; const int r0 = F.gw * rows_per;
#pragma unroll 1
    for (int r = r0; r < r0 + rows_per; r += 4) {
        f32x4 v[4][4];
#pragma unroll
        for (int q = 0; q < 4; ++q) { const f32x4* xr = (const f32x4*)(X + (size_t)(r + q) * DM) + F.lane;
#pragma unroll
            for (int j = 0; j < 4; ++j) v[q][j] = xr[64 * j]; }
#pragma unroll
        for (int q = 0; q < 4; ++q) { float s = 0.f;
#pragma unroll
            for (int j = 0; j < 4; ++j) s += (v[q][j].x * v[q][j].x + v[q][j].y * v[q][j].y) + (v[q][j].z * v[q][j].z + v[q][j].w * v[q][j].w);
            const float rstd = 1.0f / sqrtf(wave_sum(s, F.lane) * (1.0f / DM) + EPS);
            f32x4* xo = (f32x4*)(X + (size_t)(r + q) * DM) + F.lane;
#pragma unroll
            for (int j = 0; j < 4; ++j) xo[64 * j] = v[q][j] * rstd * g[j]; }
    }
}

__device__ __forceinline__ void phase_qknorm(const Ctx& F, const Args& a, int j) {
    const bf16_t* QKV = (const bf16_t*)(a.ws + R_QKV); bf16_t* Qn = (bf16_t*)(a.ws + R_QN); bf16_t* Kn = (bf16_t*)(a.ws + R_KN); bf16_t* Vc = (bf16_t*)(a.ws + R_VC);
    const float* qg = a.in[9] + j * 64; const float* kg = a.in[10] + j * 64;
    const int sub = F.lane & 15, e0 = sub * 4, hsel = F.lane >> 4;
    const f32x4 gq = *(const f32x4*)(qg + e0), gk = *(const f32x4*)(kg + e0);
    const int i0 = 2 * sub, i1 = 2 * sub + 1;
    const float inv0 = 1.0f / powf(10000.0f, (float)(i0 & 15) / 16.0f), inv1 = 1.0f / powf(10000.0f, (float)(i1 & 15) / 16.0f);
    const float C2 = 0.125f * 1.4426950408889634f;
    const int rows_per = TOK / F.NGW; const int rbeg = F.gw * rows_per;
#pragma unroll 1
    for (int rb = rbeg; rb < rbeg + rows_per; rb += 4) {
        u32x2 wq[4][5], wv[4];
#pragma unroll
        for (int q = 0; q < 4; ++q) { const bf16_t* src = QKV + (size_t)(rb + q) * NQKV;
#pragma unroll
            for (int it = 0; it < 5; ++it) wq[q][it] = *(const u32x2*)(src + (it * 4 + hsel) * 64 + e0);
            wv[q] = *(const u32x2*)(src + 1280 + F.lane * 4); }
#pragma unroll
        for (int q = 0; q < 4; ++q) {
            const int row = rb + q; const int t = row & (SEQ - 1); const float pos = (i0 < 16) ? (float)(t >> 6) : (float)(t & 63);
            const float a0 = pos * inv0, a1 = pos * inv1; const float c0 = cosf(a0), s0 = sinf(a0), c1 = cosf(a1), s1 = sinf(a1);
#pragma unroll
            for (int it = 0; it < 5; ++it) {
                const int head = it * 4 + hsel; const u32x2 w = wq[q][it];
                float v0 = bflo(w.x), v1 = bfhi(w.x), v2 = bflo(w.y), v3 = bfhi(w.y);
                float ss = v0 * v0 + v1 * v1 + v2 * v2 + v3 * v3;
                ss += bperm(ss, F.lane ^ 1); ss += bperm(ss, F.lane ^ 2); ss += bperm(ss, F.lane ^ 4); ss += bperm(ss, F.lane ^ 8);
                const float rstd = 1.0f / sqrtf(ss * (1.0f / 64.0f) + EPS);
                const f32x4 gg = (it < 4) ? gq : gk;
                v0 *= rstd * gg.x; v1 *= rstd * gg.y; v2 *= rstd * gg.z; v3 *= rstd * gg.w;
                float o0 = v0 * c0 - v1 * s0, o1 = v0 * s0 + v1 * c0, o2 = v2 * c1 - v3 * s1, o3 = v2 * s1 + v3 * c1;
                if (it < 4) { o0 *= C2; o1 *= C2; o2 *= C2; o3 *= C2; *(u32x2*)(Qn + (size_t)row * 1024 + head * 64 + e0) = (u32x2){pk2(o0, o1), pk2(o2, o3)}; }
                else *(u32x2*)(Kn + (size_t)row * 256 + (head - 16) * 64 + e0) = (u32x2){pk2(o0, o1), pk2(o2, o3)};
            }
            *(u32x2*)(Vc + (size_t)row * 256 + F.lane * 4) = wv[q];
        }
    }
}

__device__ __forceinline__ void phase_ffnfix(const Ctx& F, const Args& a, int layer) {
    bf16_t* Gb = (bf16_t*)(a.ws + R_G); const float* halo = (const float*)(a.ws + R_HALO);
    const float* cw = a.in[32] + (size_t)layer * 3 * DFF; const float* cb = a.in[33] + (size_t)layer * DFF;
    for (int it = F.gw; it < 128 * 2 * 11; it += F.NGW) {
        const int seg = it % 11, lastrow = (it / 11) & 1, pm = it / 22; const int c = seg * 256 + F.lane * 4;
        const float* hp = halo + (size_t)pm * 6 * DFF + c;
        f32x4 pv, cv, nv, vv;
        if (!lastrow) { pv = (pm % 32 == 0) ? (f32x4){0.f, 0.f, 0.f, 0.f} : *(const f32x4*)(hp - 6 * DFF + 3 * DFF); cv = *(const f32x4*)hp; nv = *(const f32x4*)(hp + DFF); vv = *(const f32x4*)(hp + 4 * DFF); }
        else { pv = *(const f32x4*)(hp + 2 * DFF); cv = *(const f32x4*)(hp + 3 * DFF); nv = (pm % 32 == 31) ? (f32x4){0.f, 0.f, 0.f, 0.f} : *(const f32x4*)(hp + 6 * DFF); vv = *(const f32x4*)(hp + 5 * DFF); }
        const f32x4 w0 = *(const f32x4*)(cw + c), w1 = *(const f32x4*)(cw + DFF + c), w2 = *(const f32x4*)(cw + 2 * DFF + c), bb = *(const f32x4*)(cb + c);
        const f32x4 gt = pv * w0 + cv * w1 + nv * w2 + bb; float o[4];
#pragma unroll
        for (int e = 0; e < 4; ++e) o[e] = gt[e] * sigmoidf_(gt[e]) * vv[e];
        *(u32x2*)(Gb + (size_t)(pm * 256 + (lastrow ? 255 : 0)) * DFF + c) = (u32x2){pk2(o[0], o[1]), pk2(o[2], o[3])};
    }
}

__device__ __forceinline__ void phase_hyconvT(const Ctx& F, const Args& a) {
    const bf16_t* Up = (const bf16_t*)(a.ws + R_UPRE); const float* cw = a.in[12]; const float* cb = a.in[13];
    for (int it = F.gw; it < 4 * 3 * 16 * 128; it += F.NGW) {
        const int tb = it & 127, cbk = (it >> 7) & 15, part = (it >> 11) % 3, b = it / (3 * 2048);
        const int col = part * 1024 + cbk * 64 + F.lane; const int t0 = tb * 64;
        bf16_t* dst = (bf16_t*)(a.ws + (part == 0 ? WS_H : part == 1 ? R_X1 : R_X2)) + ((size_t)(b * 1024 + cbk * 64 + F.lane)) * SEQ + t0;
        const float w0 = cw[col], w1 = cw[3072 + col], w2 = cw[6144 + col], bb = cb[col];
        const bf16_t* sp = Up + ((size_t)b * SEQ + t0) * 3072 + col;
        unsigned short pv[66];
#pragma unroll
        for (int i = 0; i < 66; ++i) { const int t = t0 - 1 + i; pv[i] = (t >= 0 && t < SEQ) ? sp[(ptrdiff_t)(i - 1) * 3072] : (unsigned short)0; }
#pragma unroll
        for (int q = 0; q < 8; ++q) {
            float o[8];
#pragma unroll
            for (int e = 0; e < 8; ++e) { const int tt = q * 8 + e; o[e] = bf2f(pv[tt]) * w0 + bf2f(pv[tt + 1]) * w1 + bf2f(pv[tt + 2]) * w2 + bb; }
            *(u32x4*)(dst + q * 8) = (u32x4){pk2(o[0], o[1]), pk2(o[2], o[3]), pk2(o[4], o[5]), pk2(o[6], o[7])};
        }
    }
}
__device__ __forceinline__ void phase_hytr(const Ctx& F, const Args& a) {
    const bf16_t* Z2 = (const bf16_t*)(a.ws + R_Z2); bf16_t* H = (bf16_t*)(a.ws + R_Z2T);
    for (int it = F.gw; it < 4 * 16 * 128; it += F.NGW) {
        const int tb = it & 127, cbk = (it >> 7) & 15, b = it >> 11; const int t0 = tb * 64, c = cbk * 64 + F.lane;
        const bf16_t* sp = Z2 + ((size_t)(b * 1024 + c)) * SEQ + t0; bf16_t* dp = H + ((size_t)b * SEQ + t0) * 1024 + c;
        u32x4 wq[8];
#pragma unroll
        for (int q = 0; q < 8; ++q) wq[q] = *(const u32x4*)(sp + q * 8);
#pragma unroll
        for (int q = 0; q < 8; ++q) { const u32x4 w = wq[q]; bf16_t* d = dp + (size_t)(q * 8) * 1024;
            d[0] = (bf16_t)(w.x & 0xffff); d[1024] = (bf16_t)(w.x >> 16); d[2048] = (bf16_t)(w.y & 0xffff); d[3072] = (bf16_t)(w.y >> 16);
            d[4096] = (bf16_t)(w.z & 0xffff); d[5120] = (bf16_t)(w.z >> 16); d[6144] = (bf16_t)(w.w & 0xffff); d[7168] = (bf16_t)(w.w >> 16); }
    }
}

constexpr int FN = 16384;
constexpr int A2S = SEQ + 64;
__device__ __forceinline__ int fswz(int i) { return i ^ ((i >> 5) & 31); }
__host__ __device__ constexpr float cos16(int k) { k &= 15; return k == 0 ? 1.f : k == 1 ? 0.92387953251f : k == 2 ? 0.70710678119f : k == 3 ? 0.38268343237f : k == 4 ? 0.f : k == 5 ? -0.38268343237f : k == 6 ? -0.70710678119f : k == 7 ? -0.92387953251f
    : k == 8 ? -1.f : k == 9 ? -0.92387953251f : k == 10 ? -0.70710678119f : k == 11 ? -0.38268343237f : k == 12 ? 0.f : k == 13 ? 0.38268343237f : k == 14 ? 0.70710678119f : 0.92387953251f; }
__host__ __device__ constexpr float sin16(int k) { return cos16(k + 12); }
template <int R, int LSTR, bool INV, int NG>
__device__ __forceinline__ void fft_stages(f32x2 (&v)[NG][1 << R], const int (&jv)[NG]) {
    constexpr int NE = 1 << R;
#pragma unroll
    for (int rr = 0; rr < R; ++rr) {
        const int r = INV ? (R - 1 - rr) : rr; const int dq = 1 << (R - 1 - r);
#pragma unroll
        for (int gI = 0; gI < NG; ++gI) {
            const float fr0 = (float)jv[gI] * (1.0f / (float)(1 << (LSTR + R - r)));
            const float cs = __builtin_amdgcn_cosf(fr0), sn = __builtin_amdgcn_sinf(fr0);
            const f32x2 w0 = {cs, INV ? sn : -sn};
#pragma unroll
            for (int q = 0; q < NE; ++q) if (!(q & dq)) {
                const int m = q & (dq - 1); const int k16 = m << (4 - (R - r));
                const float cr = cos16(k16), ci = INV ? sin16(k16) : -sin16(k16);
                f32x2 tw; if (m == 0) tw = w0; else tw = w0 * cr + (f32x2){-w0.y, w0.x} * ci;
                const f32x2 twp = {-tw.y, tw.x};
                const f32x2 x = v[gI][q], y = v[gI][q + dq];
                if (!INV) { const f32x2 d = x - y; v[gI][q] = x + y; v[gI][q + dq] = twp * d.y + tw * d.x; }
                else { const f32x2 yt = twp * y.y + tw * y.x; v[gI][q] = x + yt; v[gI][q + dq] = x - yt; }
            }
        }
    }
}
template <int R, int LSTR, bool INV>
__device__ __forceinline__ void fft_pass(LAS f32x2* cb, int tid) {
    constexpr int NE = 1 << R, STR = 1 << LSTR, NG = (R == 4) ? 2 : 1;
#pragma unroll 1
    for (int gi = tid; gi < (FN >> R); gi += 512 * NG) {
        int g2 = gi; asm volatile("" : "+v"(g2));
        int jv[NG], base[NG];
#pragma unroll
        for (int gI = 0; gI < NG; ++gI) { const int gg = g2 + 512 * gI; jv[gI] = gg & (STR - 1); base[gI] = ((gg >> LSTR) << (LSTR + R)) + jv[gI]; }
        f32x2 v[NG][NE];
#pragma unroll
        for (int gI = 0; gI < NG; ++gI)
#pragma unroll
            for (int q = 0; q < NE; ++q) v[gI][q] = cb[fswz(base[gI] + (q << LSTR))];
        fft_stages<R, LSTR, INV, NG>(v, jv);
#pragma unroll
        for (int gI = 0; gI < NG; ++gI)
#pragma unroll
            for (int q = 0; q < NE; ++q) cb[fswz(base[gI] + (q << LSTR))] = v[gI][q];
    }
    __syncthreads();
}
__device__ __forceinline__ void fft_fwd(LAS f32x2* cb, int tid) { fft_pass<4, 10, false>(cb, tid); fft_pass<4, 6, false>(cb, tid); fft_pass<4, 2, false>(cb, tid); fft_pass<2, 0, false>(cb, tid); }
__device__ __forceinline__ void fft_inv(LAS f32x2* cb, int tid) { fft_pass<2, 0, true>(cb, tid); fft_pass<4, 2, true>(cb, tid); fft_pass<4, 6, true>(cb, tid); fft_pass<4, 10, true>(cb, tid); }

__device__ __forceinline__ void fft_mid(LAS f32x2* cb, const f32x2* __restrict__ KFo, int tid) {
    f32x4 kk[16];
    { int tq = tid; asm volatile("" : "+v"(tq)); tid = tq; }
#pragma unroll
    for (int i = 0; i < 8; ++i) { const f32x2* kp = KFo + (size_t)(tid + 512 * i) * 4; kk[2 * i] = *(const f32x4*)kp; kk[2 * i + 1] = *(const f32x4*)(kp + 2); }
#pragma unroll
    for (int i = 0; i < 8; ++i) {
        const int base = (tid + 512 * i) << 2;
        f32x2 v[4]; f32x2 k[4];
#pragma unroll
        for (int q = 0; q < 4; ++q) v[q] = cb[fswz(base + q)];
        k[0] = (f32x2){kk[2 * i].x, kk[2 * i].y}; k[1] = (f32x2){kk[2 * i].z, kk[2 * i].w}; k[2] = (f32x2){kk[2 * i + 1].x, kk[2 * i + 1].y}; k[3] = (f32x2){kk[2 * i + 1].z, kk[2 * i + 1].w};
        { const f32x2 a = v[0] + v[2], b = v[0] - v[2], c = v[1] + v[3], d = v[1] - v[3]; const f32x2 dm = {d.y, -d.x};
          v[0] = a + c; v[1] = a - c; v[2] = b + dm; v[3] = b - dm; }
#pragma unroll
        for (int q = 0; q < 4; ++q) { const f32x2 z = v[q]; v[q] = k[q] * z.x + (f32x2){-k[q].y, k[q].x} * z.y; }
        { const f32x2 a = v[0] + v[1], b = v[0] - v[1], c = v[2] + v[3], d = v[2] - v[3]; const f32x2 dp = {-d.y, d.x};
          v[0] = a + c; v[2] = a - c; v[1] = b + dp; v[3] = b - dp; }
#pragma unroll
        for (int q = 0; q < 4; ++q) cb[fswz(base + q)] = v[q];
    }
    __syncthreads();
}
__device__ __forceinline__ void fft_fwd3(LAS f32x2* cb, int tid) { fft_pass<4, 10, false>(cb, tid); fft_pass<4, 6, false>(cb, tid); fft_pass<4, 2, false>(cb, tid); }
__device__ __forceinline__ void fft_inv3(LAS f32x2* cb, int tid) { fft_pass<4, 2, true>(cb, tid); fft_pass<4, 6, true>(cb, tid); fft_pass<4, 10, true>(cb, tid); }
__device__ __forceinline__ float block_sum(float v, LAS float* red, int tid) {
    v = wave_sum(v, tid & 63); __syncthreads(); if ((tid & 63) == 0) red[tid >> 6] = v; __syncthreads();
    float s = 0.f;
#pragma unroll
    for (int w = 0; w < 8; ++w) s += red[w];
    return s;
}
__device__ __forceinline__ void hy_conv16(const bf16_t* rowp, int t0, float w0, float w1, float w2, float bb, float (&out)[16]) {
    const u32x4 a0 = *(const u32x4*)(rowp + t0), a1 = *(const u32x4*)(rowp + t0 + 8);
    const float lft = (t0 > 0) ? bf2f(rowp[t0 - 1]) : 0.f, rgt = (t0 + 16 < SEQ) ? bf2f(rowp[t0 + 16]) : 0.f;
    float p[18]; p[0] = lft; p[17] = rgt;
#pragma unroll
    for (int e = 0; e < 4; ++e) { p[1 + 2 * e] = bflo(a0[e]); p[2 + 2 * e] = bfhi(a0[e]); p[9 + 2 * e] = bflo(a1[e]); p[10 + 2 * e] = bfhi(a1[e]); }
#pragma unroll
    for (int e = 0; e < 16; ++e) out[e] = w0 * p[e] + w1 * p[e + 1] + w2 * p[e + 2] + bb;
}
__device__ __forceinline__ void phase_hyfft(const Ctx& F, const Args& a) {
    LAS f32x2* cb = (LAS f32x2*)F.lds; LAS float* red = (LAS float*)(F.lds + MISC_OFF); LAS f32x4* w3l = (LAS f32x4*)(F.lds + MISC_OFF + 256);
    const float* A2 = (const float*)(a.ws + WS_A2); const float* w3 = a.in[18]; const float* skip = a.in[20];
    const bf16_t* UT = (const bf16_t*)(a.ws + R_UPRE); const float* cwp = a.in[12]; const float* cbp = a.in[13];
    float* Z1 = (float*)(a.ws + R_Z1S) + (size_t)F.bid * 4 * SEQ; f32x2* KF = (f32x2*)(a.ws + R_KFS) + (size_t)F.bid * 2 * FN; bf16_t* Z2 = (bf16_t*)(a.ws + R_Z2);
    const int tid = F.tid;
    for (int d = F.bid; d < DM; d += F.G) {
        __syncthreads();
        if (tid < 64) w3l[tid] = (f32x4){w3[tid * 4096 + d], w3[tid * 4096 + 1024 + d], w3[tid * 4096 + 2048 + d], w3[tid * 4096 + 3072 + d]};
        __syncthreads();
        const float dlo = -3.0701134573253946f, dhi = -15.350567286626973f; const float delta = fabsf(dlo + (float)d * ((dhi - dlo) / 1023.0f));
        float n0 = 0.f, n1 = 0.f;
        {
            f32x4 acc[16];
#pragma unroll
            for (int i = 0; i < 16; ++i) acc[i] = (f32x4){0.f, 0.f, 0.f, 0.f};
            int tq = tid; asm volatile("" : "+v"(tq));
            const float* ap = A2 + 4 * tq;
            f32x4 bA[8], bB[8];
#define HY_LD(buf, c) do { _Pragma("unroll") for (int jl = 0; jl < 2; ++jl) _Pragma("unroll") for (int i = 0; i < 4; ++i) buf[jl * 4 + i] = *(const f32x4*)(ap + (size_t)((c) * 2 + jl) * A2S + 2048 * i); } while (0)
#define HY_CP(buf, c) do { _Pragma("unroll") for (int jl = 0; jl < 2; ++jl) { const f32x4 w = w3l[(c) * 2 + jl]; _Pragma("unroll") for (int i = 0; i < 4; ++i) { const f32x4 av = buf[jl * 4 + i]; \
                acc[i * 4 + 0] = acc[i * 4 + 0] + w * av.x; acc[i * 4 + 1] = acc[i * 4 + 1] + w * av.y; acc[i * 4 + 2] = acc[i * 4 + 2] + w * av.z; acc[i * 4 + 3] = acc[i * 4 + 3] + w * av.w; } } } while (0)
            f32x4 bC[8];
            HY_LD(bA, 0); HY_LD(bB, 1);
#pragma unroll 1
            for (int c = 0; c < 30; c += 3) { HY_LD(bC, c + 2); HY_CP(bA, c); HY_LD(bA, c + 3); HY_CP(bB, c + 1); HY_LD(bB, c + 4); HY_CP(bC, c + 2); }
            HY_CP(bA, 30); HY_CP(bB, 31);
#undef HY_LD
#undef HY_CP
#pragma unroll
            for (int i = 0; i < 4; ++i)
#pragma unroll
                for (int e = 0; e < 4; ++e) { const int t = 4 * tq + 2048 * i + e;
                    const float dec = expf(-((float)t * (1.0f / (float)(SEQ - 1))) * delta); const f32x4 sv = acc[i * 4 + e] * dec;
                    cb[fswz(t)] = (f32x2){sv.x, sv.z}; n0 += fabsf(sv.x); n1 += fabsf(sv.z);
                    if (t > 0) { cb[fswz(2 * SEQ - t)] = (f32x2){sv.y, sv.w}; n0 += fabsf(sv.y); n1 += fabsf(sv.w); } else { float z = 0.f; asm volatile("" : "+v"(z)); cb[fswz(SEQ)] = (f32x2){z, z}; } }
        }
        n0 = block_sum(n0, red, tid); n1 = block_sum(n1, red, tid);
        __syncthreads();
        fft_fwd(cb, tid);
        { const float s0 = 0.5f / (n0 * (float)FN), s1 = 0.5f / (n1 * (float)FN);
#pragma unroll 2
          for (int p0_ = tid; p0_ < FN; p0_ += 512) { int p = p0_; asm volatile("" : "+v"(p)); const int f = (int)(__brev((unsigned)p) >> 18); const int p2 = (int)(__brev((unsigned)((FN - f) & (FN - 1))) >> 18);
              const f32x2 z = cb[fswz(p)], zc = cb[fswz(p2)];
              KF[p] = (f32x2){(z.x + zc.x) * s0, (z.y - zc.y) * s0};
              KF[FN + p] = (f32x2){(z.y + zc.y) * s1, -(z.x - zc.x) * s1}; } }
        __syncthreads();
        const float sk0 = skip[d], sk1 = skip[1024 + d];
        const float cv0 = cwp[d], cv1 = cwp[3072 + d], cv2 = cwp[6144 + d], cvb = cbp[d];
        const float c10 = cwp[1024 + d], c11 = cwp[3072 + 1024 + d], c12 = cwp[6144 + 1024 + d], c1b = cbp[1024 + d];
        const float c20 = cwp[2048 + d], c21 = cwp[3072 + 2048 + d], c22 = cwp[6144 + 2048 + d], c2b = cbp[2048 + d];
        const bf16_t* Vr = UT + (size_t)d * TOK; const bf16_t* X1r = UT + (size_t)(1024 + d) * TOK; const bf16_t* X2r = UT + (size_t)(2048 + d) * TOK;
#pragma unroll 1
        for (int o = 0; o < 2; ++o) {
#pragma unroll 1
            for (int pr = 0; pr < 2; ++pr) {
                const int b0 = 2 * pr, b1 = 2 * pr + 1;
                {   int tq = tid; asm volatile("" : "+v"(tq)); const int t0 = tq * 16; float zr[16], zi[16];
                    if (o == 0) { hy_conv16(Vr + (size_t)b0 * SEQ, t0, cv0, cv1, cv2, cvb, zr); hy_conv16(Vr + (size_t)b1 * SEQ, t0, cv0, cv1, cv2, cvb, zi); }
                    else { const f32x4* p0 = (const f32x4*)(Z1 + b0 * SEQ + t0); const f32x4* p1 = (const f32x4*)(Z1 + b1 * SEQ + t0);
#pragma unroll
                        for (int q = 0; q < 4; ++q) { const f32x4 a = p0[q], c = p1[q];
#pragma unroll
                            for (int e = 0; e < 4; ++e) { zr[4 * q + e] = a[e]; zi[4 * q + e] = c[e]; } } }
                    float z = 0.f; asm volatile("" : "+v"(z));
#pragma unroll
                    for (int e = 0; e < 16; ++e) { cb[fswz(t0 + e)] = (f32x2){zr[e], zi[e]}; cb[fswz(SEQ + t0 + e)] = (f32x2){z, z}; } }
                __syncthreads();
                fft_fwd3(cb, tid);
                fft_mid(cb, KF + o * FN, tid);
                fft_inv3(cb, tid);
                {   int tq = tid; asm volatile("" : "+v"(tq)); const int t0 = tq * 16; const size_t i0 = ((size_t)(b0 * 1024 + d)) * SEQ + t0, i1 = ((size_t)(b1 * 1024 + d)) * SEQ + t0;
                    float y0[16], y1[16];
                    if (o == 0) {
                        float xa[16], xb[16], va[16], vb[16];
                        hy_conv16(X1r + (size_t)b0 * SEQ, t0, c10, c11, c12, c1b, xa); hy_conv16(X1r + (size_t)b1 * SEQ, t0, c10, c11, c12, c1b, xb);
                        hy_conv16(Vr + (size_t)b0 * SEQ, t0, cv0, cv1, cv2, cvb, va); hy_conv16(Vr + (size_t)b1 * SEQ, t0, cv0, cv1, cv2, cvb, vb);
#pragma unroll
                        for (int e = 0; e < 16; ++e) { const f32x2 y = cb[fswz(t0 + e)]; y0[e] = xa[e] * (y.x + sk0 * va[e]); y1[e] = xb[e] * (y.y + sk0 * vb[e]); }
                        f32x4* q0 = (f32x4*)(Z1 + b0 * SEQ + t0); f32x4* q1 = (f32x4*)(Z1 + b1 * SEQ + t0);
#pragma unroll
                        for (int q = 0; q < 4; ++q) { q0[q] = (f32x4){y0[4 * q], y0[4 * q + 1], y0[4 * q + 2], y0[4 * q + 3]}; q1[q] = (f32x4){y1[4 * q], y1[4 * q + 1], y1[4 * q + 2], y1[4 * q + 3]}; }
                    } else {
                        float xa[16], xb[16];
                        hy_conv16(X2r + (size_t)b0 * SEQ, t0, c20, c21, c22, c2b, xa); hy_conv16(X2r + (size_t)b1 * SEQ, t0, c20, c21, c22, c2b, xb);
                        const f32x4* z0 = (const f32x4*)(Z1 + b0 * SEQ + t0); const f32x4* z1p = (const f32x4*)(Z1 + b1 * SEQ + t0);
                        float za[16], zb[16];
#pragma unroll
                        for (int q = 0; q < 4; ++q) { const f32x4 a = z0[q], c = z1p[q];
#pragma unroll
                            for (int e = 0; e < 4; ++e) { za[4 * q + e] = a[e]; zb[4 * q + e] = c[e]; } }
#pragma unroll
                        for (int e = 0; e < 16; ++e) { const f32x2 y = cb[fswz(t0 + e)]; y0[e] = xa[e] * (y.x + sk1 * za[e]); y1[e] = xb[e] * (y.y + sk1 * zb[e]); }
                        u32x4 oa0, oa1, ob0, ob1;
#pragma unroll
                        for (int e = 0; e < 4; ++e) { oa0[e] = pk2(y0[2 * e], y0[2 * e + 1]); oa1[e] = pk2(y0[8 + 2 * e], y0[9 + 2 * e]); ob0[e] = pk2(y1[2 * e], y1[2 * e + 1]); ob1[e] = pk2(y1[8 + 2 * e], y1[9 + 2 * e]); }
                        *(u32x4*)(Z2 + i0) = oa0; *(u32x4*)(Z2 + i0 + 8) = oa1; *(u32x4*)(Z2 + i1) = ob0; *(u32x4*)(Z2 + i1 + 8) = ob1;
                    }
                }
                __syncthreads();
            }
        }
    }
}

__device__ __forceinline__ void phase_s5prep(const Ctx& F, const Args& a) {
    const float* KT = (const float*)(a.ws + WS_KTAB); const f32x2* LP = (const f32x2*)(a.ws + WS_LP); const f32x2* BB = (const f32x2*)(a.ws + WS_BBAR);
    const float *Cre = a.in[27], *Cim = a.in[28], *Dsk = a.in[29];
    bf16_t* Bt = (bf16_t*)(a.ws + R_BT1); bf16_t* Cm = (bf16_t*)(a.ws + R_CM);
    for (int it = F.gw; it < 64 * 512; it += F.NGW) {
        const int g = it >> 9, n = it & 511, to = n >> 4, ho = n & 15; const int k0 = F.lane * 8, ti = k0 >> 4, hi0 = k0 & 15;
        float o[8];
#pragma unroll
        for (int e = 0; e < 8; ++e) { float v = 0.f;
            if (to >= ti) v += KT[(((size_t)(g * 2 + 0) * 32 + (to - ti)) * 16 + ho) * 16 + hi0 + e];
            if (ti >= to) v += KT[(((size_t)(g * 2 + 1) * 32 + (ti - to)) * 16 + ho) * 16 + hi0 + e];
            if (ti == to && hi0 + e == ho) v += Dsk[g * 16 + ho];
            o[e] = v; }
        *(u32x4*)(Bt + ((size_t)g * 768 + n) * 512 + k0) = (u32x4){pk2(o[0], o[1]), pk2(o[2], o[3]), pk2(o[4], o[5]), pk2(o[6], o[7])};
    }
    for (int it = F.gw; it < 64 * 256; it += F.NGW) {
        const int g = it >> 8, np = it & 255, dir = np >> 7, im = (np >> 6) & 1, p = np & 63; const int k0 = F.lane * 8, tl = k0 >> 4, hi0 = k0 & 15;
        const int pw = dir ? tl : 31 - tl; const f32x2 l = LP[((size_t)(g * 2 + dir) * 33 + pw) * 64 + p];
        float o[8];
#pragma unroll
        for (int e = 0; e < 8; ++e) { const f32x2 b = BB[((size_t)(g * 2 + dir) * 64 + p) * 16 + hi0 + e]; o[e] = im ? (l.x * b.y + l.y * b.x) : (l.x * b.x - l.y * b.y); }
        *(u32x4*)(Bt + ((size_t)g * 768 + 512 + np) * 512 + k0) = (u32x4){pk2(o[0], o[1]), pk2(o[2], o[3]), pk2(o[4], o[5]), pk2(o[6], o[7])};
    }
    for (int it = F.gw; it < 64 * 512; it += F.NGW) {
        const int g = it >> 9, n = it & 511, tl = n >> 4, ho = n & 15;
#pragma unroll
        for (int q = 0; q < 4; ++q) { const int kp = q * 64 + F.lane, dir = kp >> 7, im = (kp >> 6) & 1, p = kp & 63; const int pw = dir ? 32 - tl : tl + 1;
            const f32x2 l = LP[((size_t)(g * 2 + dir) * 33 + pw) * 64 + p]; const size_t ci = ((size_t)(dir * 64 + g) * 16 + ho) * 64 + p; const float cr = Cre[ci], cm = Cim[ci];
            const float v = im ? -(cr * l.y + cm * l.x) : (cr * l.x - cm * l.y);
            Cm[((size_t)g * 512 + n) * 256 + kp] = (bf16_t)f2bf(v); }
    }
}
__device__ __forceinline__ void phase_s5scan(const Ctx& F, const Args& a) {
    const float* S = (const float*)(a.ws + R_S); bf16_t* Xc = (bf16_t*)(a.ws + R_XC); const f32x2* LP = (const f32x2*)(a.ws + WS_LP);
    for (int it = F.gw; it < 64 * 2 * 4; it += F.NGW) {
        const int b = it & 3, dir = (it >> 2) & 1, g = it >> 3, p = F.lane;
        const f32x2 l = LP[((size_t)(g * 2 + dir) * 33 + 32) * 64 + p];
        float xr = 0.f, xi = 0.f;
        const size_t base = ((size_t)g * 1024 + b * 256) * 256 + dir * 128 + p;
#pragma unroll 1
        for (int c0 = 0; c0 < 256; c0 += 16) {
            float sr[16], si[16];
#pragma unroll
            for (int k = 0; k < 16; ++k) { const int c = dir ? 255 - (c0 + k) : (c0 + k); const size_t o = base + (size_t)c * 256; sr[k] = S[o]; si[k] = S[o + 64]; }
#pragma unroll
            for (int k = 0; k < 16; ++k) { const int c = dir ? 255 - (c0 + k) : (c0 + k); const size_t o = base + (size_t)c * 256;
                Xc[o] = (bf16_t)f2bf(xr); Xc[o + 64] = (bf16_t)f2bf(xi);
                const float nr = l.x * xr - l.y * xi + sr[k], ni = l.x * xi + l.y * xr + si[k]; xr = nr; xi = ni; }
        }
    }
}

#define GAS __attribute__((address_space(1)))
typedef GAS unsigned gu32;
#define XB_TMO      128
#define XB_XCNT(j)  (256  + 64 * (j))
#define XB_XSUB(j)  (1280 + 64 * (j))
#define XB_XGEN(j)  (2304 + 64 * (j))
#define XB_TOP      3328
#define XB_TOPGEN   3392
#define XCD_BAR_WORDS 3456
#define XB_SPIN_CAP (1u << 18)

__device__ __forceinline__ unsigned xb_ld(unsigned* p)              { return __hip_atomic_load(p, __ATOMIC_RELAXED, __HIP_MEMORY_SCOPE_AGENT); }
__device__ __forceinline__ unsigned xb_add(unsigned* p, unsigned v) { return __hip_atomic_fetch_add(p, v, __ATOMIC_RELAXED, __HIP_MEMORY_SCOPE_AGENT); }
__device__ __forceinline__ unsigned xb_xcc_id() { return (unsigned)__builtin_amdgcn_s_getreg((3 << 11) | 20) & 0xFu; }
#define XB_SPIN(cond, bar) do { unsigned _sp = 0; while (cond) { __builtin_amdgcn_s_sleep(1); \
    if ((++_sp & 255u) == 0u) { if (xb_ld(&(bar)[XB_TMO])) break; if (_sp > XB_SPIN_CAP) { atomicAdd(&(bar)[XB_TMO], 1u); break; } } } } while (0)

struct XcdBarrier {
    unsigned* bar; unsigned x;
    volatile LAS unsigned* st;
};

__device__ __forceinline__ XcdBarrier xcd_barrier_post(unsigned* bar, volatile LAS unsigned* st) {
    XcdBarrier b; b.bar = bar; b.x = xb_xcc_id(); b.st = st;
    if (threadIdx.x == 0) (void)xb_add(&bar[XB_XCNT(b.x)], 1u);
    return b;
}
__device__ __forceinline__ void xcd_barrier_complete(unsigned* bar, unsigned x, unsigned& nloc, unsigned& nx) {
    const unsigned G = gridDim.x * gridDim.y * gridDim.z;
    unsigned sum, cnt, mine, sp = 0u;
    for (;;) {
        sum = 0u; cnt = 0u; mine = 0u;
#pragma unroll
        for (unsigned j = 0; j < 16; ++j) { const unsigned c = xb_ld(&bar[XB_XCNT(j)]); sum += c; cnt += (c > 0u) ? 1u : 0u; mine = (j == x) ? c : mine; }
        if (sum == G) break;
        __builtin_amdgcn_s_sleep(1);
        if ((++sp & 255u) == 0u) { if (xb_ld(&bar[XB_TMO])) break; if (sp > XB_SPIN_CAP) { atomicAdd(&bar[XB_TMO], 1u); break; } }
    }
    nloc = mine > 0u ? mine : 1u; nx = cnt > 0u ? cnt : 1u;
}

__device__ __forceinline__ void xcd_barrier(const XcdBarrier& b) {
    asm volatile("s_waitcnt vmcnt(0)" ::: "memory");
    __syncthreads();
    if (threadIdx.x == 0) {
        unsigned* bar = b.bar;
        __builtin_amdgcn_s_waitcnt(0);
        unsigned nloc = b.st[0], nx = b.st[1];
        if (nloc == 0u) { xcd_barrier_complete(bar, b.x, nloc, nx); b.st[0] = nloc; b.st[1] = nx; }
        const unsigned old = xb_add(&bar[XB_XSUB(b.x)], 1u);
        const unsigned gen = old / nloc;
        if (old + 1u == (gen + 1u) * nloc) {
            __builtin_amdgcn_fence(__ATOMIC_RELEASE, "agent");
            asm volatile("s_waitcnt vmcnt(0)" ::: "memory");
            const unsigned og = xb_add(&bar[XB_TOP], 1u);
            const unsigned tg = og / nx;
            if (og + 1u == (tg + 1u) * nx) xb_add(&bar[XB_TOPGEN], 1u);
            else XB_SPIN(xb_ld(&bar[XB_TOPGEN]) == tg, bar);
            __builtin_amdgcn_fence(__ATOMIC_ACQUIRE, "agent");
            xb_add(&bar[XB_XGEN(b.x)], 1u);
            asm volatile("s_waitcnt vmcnt(0)" ::: "memory");
        } else {
            XB_SPIN(xb_ld(&bar[XB_XGEN(b.x)]) == gen, bar);
            __builtin_amdgcn_fence(__ATOMIC_ACQUIRE, "agent");
            asm volatile("s_waitcnt vmcnt(0)" ::: "memory");
        }
    }
    __syncthreads();
}

__device__ __forceinline__ pg8::Gemm std_gemm(const void* A, int lda, const void* Bt, int K) {
    pg8::Gemm g; g.A = (const char*)A; g.B = (const char*)Bt; g.nt = K / 64; g.a_row = lda; g.a_seg = 16; g.a_kstep = 128; g.a_g = 0; g.ldb = K; g.b_g = 0; return g;
}
__global__ void __launch_bounds__(NWAVES * 64, 2) mk_fwd(Args args0) {
    extern __shared__ __attribute__((aligned(16))) unsigned char lds[];
    cg::grid_group grid = cg::this_grid();
    const int ph_lo = args0.ph_lo, ph_hi = args0.ph_hi;
    volatile LAS unsigned* MISC = (volatile LAS unsigned*)((LAS unsigned char*)lds + MISC_OFF + 8192);
    if (threadIdx.x < 32) MISC[threadIdx.x] = 0u;
    __syncthreads();
    (void)xcd_barrier_post((unsigned*)(args0.ws + WS_BAR), MISC + 8);
    for (int ph = ph_lo; ph < ph_hi; ++ph) {
        typedef const __attribute__((address_space(4))) Args* KArgs;
        KArgs kap = (KArgs)__builtin_amdgcn_kernarg_segment_ptr(); asm volatile("" : "+s"(kap));
        const Args& args = *(const Args*)kap;
        Ctx F; F.lds = (LAS unsigned char*)lds; F.tid = ltid(); F.lane = F.tid & 63; F.wave = __builtin_amdgcn_readfirstlane(F.tid >> 6);
        const int bx = lbid(); F.G = lgrid(); F.bid = bx; F.vcu = (F.G % 8 == 0) ? (bx % 8) * (F.G / 8) + bx / 8 : bx;
        F.gw = bx * NWAVES + F.wave; F.NGW = F.G * NWAVES;
        unsigned char* ws = args.ws; bf16_t* Wb = (bf16_t*)(ws + WS_W); const float* mod = (const float*)(ws + WS_MOD);
        float* SSb = (float*)(ws + WS_SS); const float* BIASb = (const float*)(ws + WS_BIAS);
#define NEXTNORM(ln, wn, dst) pg8::NextNorm{(bf16_t*)(dst), ((wn) ? args.in[5] : args.in[4]) + (ln) * 1024, mod + (size_t)(ln) * 4 * 6144 + (wn) * 3072 + 1024, SSb + (size_t)(2 * (ln) + (wn)) * TOK}
        const int kind = args.prog[ph][0], layer = args.prog[ph][1], aux = args.prog[ph][2], j = args.prog[ph][3] & 1, nobar = args.prog[ph][3] >> 7;
#ifndef PH_MASK
#define PH_MASK 0xffffffffu
#endif
#define EN(k) (((PH_MASK) >> (k)) & 1u)
        switch (kind) {
        case K_PRO: if (EN(K_PRO)) { phase_prologue(F, args); } break;
        case K_MODRED: if (EN(K_MODRED)) { phase_modred(F, args); } break;
        case K_NORMMOD: if (EN(K_NORMMOD)) { phase_normmod(F, args, layer, aux); if (layer == 0 && aux == 0) { phase_bias(F, args); phase_modred(F, args); } } break;
        case K_QKN: if (EN(K_QKN)) { phase_qknorm(F, args, j); } break;
        case K_ATT: if (EN(K_ATT)) { const attn_body::AttnTensors AT{(const attn_body::bf16*)(ws + R_QN), (const attn_body::bf16*)(ws + R_KN), (const attn_body::bf16*)(ws + R_VC), (attn_body::bf16*)(ws + (aux ? R_QKV : R_QN))};
            const attn_body::StaticOrder S((int)F.G, bx);
            if (F.wave >= 4) __builtin_amdgcn_s_setprio(1);
            attn_body::attn_phase<attn_body::StaticOrder>((char*)lds, AT, S);
            __builtin_amdgcn_s_setprio(0); } break;
        case K_FFNCONV: if (EN(K_FFNCONV)) { phase_ffnfix(F, args, layer); } break;
        case K_HCT: if (EN(K_HCT)) { phase_hyconvT(F, args); } break;
        case K_HFFT: if (EN(K_HFFT)) { phase_hyfft(F, args); } break;
        case K_HTR: if (EN(K_HTR)) { phase_hytr(F, args); } break;
        case K_S5PREP: if (EN(K_S5PREP)) { phase_s5prep(F, args); } break;
        case K_S5SCAN: if (EN(K_S5SCAN)) { phase_s5scan(F, args); } break;
        case K_FINAL: if (EN(K_FINAL)) { phase_final(F, args); } break;
        case K_GEMM_HIN: if (EN(K_GEMM_HIN)) {
            pg8::Gemm g = std_gemm(Wb + WO_HIN, 1024, ws + WS_H, 1024); pg8::Sched S{3072 / 256, TOK / 256, 1, F.G, bx};
            pg8::EpiBf16T E{(bf16_t*)(ws + R_UPRE), SSb + (size_t)(2 * layer) * TOK, BIASb + 22528};
            pg8::gemm_phase<pg8::EpiBf16T>(F.lds, g, S, E); } break;
        case K_GEMM_WO: case K_GEMM_DN: case K_GEMM_HOUT: if (EN(K_GEMM_WO)) {
            pg8::Gemm g; pg8::Sched S; pg8::EpiRes E;
            if (kind == K_GEMM_WO) { g = std_gemm(ws + R_QN, 1024, Wb + WO_WO(j), 1024); S = pg8::Sched{TOK / 256, 4, 1, F.G, bx}; E = pg8::EpiRes{args.out, mod + (size_t)layer * 4 * 6144 + 2048, 0, NEXTNORM(layer, 1, ws + WS_H), layer == 0 ? args.in[0] : args.out}; }
            else if (kind == K_GEMM_HOUT) { g = std_gemm(ws + R_Z2T, 1024, Wb + WO_HOUT, 1024); S = pg8::Sched{TOK / 256, 4, 1, F.G, bx}; E = pg8::EpiRes{args.out, mod + (size_t)layer * 4 * 6144 + 2048, 0, NEXTNORM(layer, 1, ws + R_H2), args.out}; }
            else { g = std_gemm(ws + R_G, DFF, Wb + WO_DN(layer), DFF); S = pg8::Sched{TOK / 256, 4, 1, F.G, bx}; E = pg8::EpiRes{args.out, mod + (size_t)layer * 4 * 6144 + 5120, 0, pg8::NextNorm{nullptr, nullptr, nullptr, nullptr}, args.out};
                if (layer < 3) { E.nn = NEXTNORM(layer + 1, 0, ws + WS_H); if (layer == 1) { E.nn.Hn = nullptr; E.nn.ssn = nullptr; } } }
            if (aux) { E.X = (float*)(ws + WS_R + 200 * MiB); E.Xr = E.X; }
            pg8::gemm_phase<pg8::EpiRes>(F.lds, g, S, E); } break;
        case K_GEMM_QKV: if (EN(K_GEMM_QKV)) { pg8::Gemm g = std_gemm(ws + WS_H, 1024, Wb + WO_QKV(j), 1024); pg8::Sched S{TOK / 256, NQKV / 256, 1, F.G, bx};
            pg8::EpiQkv E{(bf16_t*)(ws + R_QN), (bf16_t*)(ws + R_KN), (bf16_t*)(ws + R_VC), SSb + (size_t)(2 * layer) * TOK, layer == 0 ? SSb + (size_t)4 * TOK : BIASb + 25600, layer == 0 ? 0 : pg8::NBIAS,
                          args.in[9] + j * 64, args.in[10] + j * 64, (const f32x2*)(ws + WS_ROPE), (LAS float*)(F.lds + MISC_OFF + 1024), (LAS float*)(F.lds + MISC_OFF + 9216)};
            pg8::gemm_phase<pg8::EpiQkv>(F.lds, g, S, E); } break;
        case K_GEMM_UP: if (EN(K_GEMM_UP)) { pg8::Gemm g = std_gemm(layer == 1 ? ws + R_H2 : ws + WS_H, 1024, Wb + WO_UP(layer), 1024); pg8::Sched S{TOK / 256, 5632 / 256, 1, F.G, bx};
            pg8::EpiFfn E{(bf16_t*)(ws + R_G), (float*)(ws + R_HALO), args.in[32] + (size_t)layer * 3 * DFF, args.in[33] + (size_t)layer * DFF, (LAS float*)(F.lds + MISC_OFF + 1024), SSb + (size_t)(2 * layer + 1) * TOK, BIASb + (size_t)layer * 5632};
            pg8::gemm_phase<pg8::EpiFfn>(F.lds, g, S, E); } break;
        case K_GEMM_GLU: if (EN(K_GEMM_GLU)) { pg8::Gemm g = std_gemm(ws + R_YI, 1024, Wb + WO_GLU, 1024); pg8::Sched S{TOK / 256, 8, 1, F.G, bx}; pg8::EpiGlu E{args.out, mod + (size_t)layer * 4 * 6144 + 2048, NEXTNORM(layer, 1, ws + WS_H)};
            pg8::gemm_phase<pg8::EpiGlu>(F.lds, g, S, E); } break;
        case K_GEMM_S1: if (EN(K_GEMM_S1)) { pg8::Gemm g; g.A = (const char*)(ws + WS_H); g.B = (const char*)(ws + R_BT1); g.nt = 8; g.a_row = 32 * 1024; g.a_seg = 1024; g.a_kstep = 4 * 1024 * 2; g.a_g = 32; g.ldb = 512; g.b_g = (size_t)768 * 512 * 2;
            pg8::Sched S{4, 3, 64, F.G, bx}; pg8::EpiS1 E{(bf16_t*)(ws + R_YI), (float*)(ws + R_S)};
            pg8::gemm_phase<pg8::EpiS1>(F.lds, g, S, E); } break;
        case K_GEMM_S2: if (EN(K_GEMM_S2)) { pg8::Gemm g; g.A = (const char*)(ws + R_XC); g.B = (const char*)(ws + R_CM); g.nt = 4; g.a_row = 256; g.a_seg = 16; g.a_kstep = 128; g.a_g = (size_t)1024 * 256 * 2; g.ldb = 256; g.b_g = (size_t)512 * 256 * 2;
            pg8::Sched S{4, 2, 64, F.G, bx}; pg8::EpiS2 E{(bf16_t*)(ws + R_YI)};
            pg8::gemm_phase<pg8::EpiS2>(F.lds, g, S, E); } break;
        default: break;
        }
        if (ph + 1 < ph_hi && !nobar) { if (ph_hi < 0) grid.sync(); else { XcdBarrier bar; bar.bar = (unsigned*)(ws + WS_BAR); bar.x = xb_xcc_id(); bar.st = (volatile LAS unsigned*)((LAS unsigned char*)lds + MISC_OFF + 8192) + 8; xcd_barrier(bar); } } else if (nobar) __syncthreads();
    }
}

#ifndef MK_PER_PHASE
#define MK_PER_PHASE 0
#endif
extern "C" void kernel_launch(void* const* d_in, const int* in_sizes, int n_in, void* d_out, int out_size, void* d_ws, size_t ws_size, hipStream_t stream) {
    static int grid = 0;
    if (grid == 0) {
        if (n_in != 35 || out_size != TOK * DM || ws_size < WS_END) { fprintf(stderr, "kernel_launch: unexpected shapes (n_in %d out %d ws %zu)\n", n_in, out_size, ws_size); grid = -1; return; }
        int dev = 0, cus = 0, per_cu = 0;
        hipGetDevice(&dev); hipDeviceGetAttribute(&cus, hipDeviceAttributeMultiprocessorCount, dev);
        if (hipFuncSetAttribute((const void*)mk_fwd, hipFuncAttributeMaxDynamicSharedMemorySize, LDS_BYTES) != hipSuccess) { fprintf(stderr, "kernel_launch: hipFuncSetAttribute failed\n"); grid = -1; return; }
        if (hipOccupancyMaxActiveBlocksPerMultiprocessor(&per_cu, (const void*)mk_fwd, NWAVES * 64, LDS_BYTES) != hipSuccess || per_cu < 1) { fprintf(stderr, "kernel_launch: occupancy query gave %d\n", per_cu); per_cu = 1; }
        (void)hipGetLastError();
        grid = cus * 1;
    }
    if (grid < 0) return;
    Args a{};
    for (int i = 0; i < 35; ++i) a.in[i] = (const float*)d_in[i];
    a.out = (float*)d_out; a.ws = (unsigned char*)d_ws;
    int np = 0;
#ifndef PROBE_DUP
#define PROBE_DUP 0u
#endif
    auto P1 = [&](int kind, int layer, int aux, int j) { a.prog[np][0] = (unsigned char)kind; a.prog[np][1] = (unsigned char)layer; a.prog[np][2] = (unsigned char)aux; a.prog[np][3] = (unsigned char)j; ++np; };
    auto P = [&](int kind, int layer, int aux, int j) { if ((PROBE_DUP >> kind) & 1u) P1(kind, layer, (kind == K_ATT || kind == K_GEMM_WO || kind == K_GEMM_DN || kind == K_GEMM_HOUT) ? 1 : aux, j); P1(kind, layer, aux, j); };
    P(K_PRO, 0, 0, 0);
    for (int i = 0; i < 4; ++i) {
        const int m = i % 3, j = i / 3;
        if (m == 0) { if (i == 0) P(K_NORMMOD, i, 0, j); P(K_GEMM_QKV, i, 0, j); P(K_ATT, i, 0, j); P(K_GEMM_WO, i, 0, j); }
        else if (m == 1) { P(K_GEMM_HIN, i, 0, j); P(K_HFFT, i, 0, j); P(K_HTR, i, 0, j); P(K_GEMM_HOUT, i, 0, j); }
        else { P(K_NORMMOD, i, 0, j | 128); P(K_S5PREP, i, 0, j); P(K_GEMM_S1, i, 0, j);   P(K_S5SCAN, i, 0, j); P(K_GEMM_S2, i, 0, j); P(K_GEMM_GLU, i, 0, j); }
        P(K_GEMM_UP, i, 0, j); P(K_FFNCONV, i, 0, j); P(K_GEMM_DN, i, 0, j);
    }
    P(K_FINAL, 0, 0, 0);
#if MK_PER_PHASE
    for (int ph = 0; ph < np; ++ph) { a.ph_lo = ph; a.ph_hi = ph + 1; hipLaunchKernelGGL(mk_fwd, dim3(grid), dim3(NWAVES * 64), LDS_BYTES, stream, a); }
#else
    a.ph_lo = 0; a.ph_hi = np;
    (void)hipMemsetAsync((char*)d_ws + WS_MOD, 0, 4 * 4 * 6144 * 4 + 16384, stream);
    void* kargs[] = {&a};
    hipError_t e = hipLaunchCooperativeKernel((const void*)mk_fwd, dim3(grid), dim3(NWAVES * 64), kargs, LDS_BYTES, stream);
    if (e != hipSuccess) fprintf(stderr, "kernel_launch: cooperative launch failed: %s (grid %d)\n", hipGetErrorString(e), grid);
#endif
}
```

```cpp
#include <hip/hip_runtime.h>
#include <hip/hip_cooperative_groups.h>
#include <hip/hip_bf16.h>
#include <cstdio>
#include <cstdint>
#include <cmath>
namespace cg = cooperative_groups;

#define LAS __attribute__((address_space(3)))
typedef unsigned short bf16_t;
typedef short bf16x8 __attribute__((ext_vector_type(8)));
typedef float f32x4 __attribute__((ext_vector_type(4)));
typedef float f32x2 __attribute__((ext_vector_type(2)));
typedef unsigned u32x4 __attribute__((ext_vector_type(4)));
typedef unsigned u32x2 __attribute__((ext_vector_type(2)));

constexpr int NB = 4, SEQ = 8192, DM = 1024, TOK = NB * SEQ, DFF = 2816, NHEAD = 16, NKV = 4, HD = 64, NQKV = 1536;
constexpr float EPS = 1e-6f;
constexpr int NWAVES = 8;

__device__ __forceinline__ unsigned f2bf(float f) { unsigned u = __builtin_bit_cast(unsigned, f); return (u + 0x7fffu + ((u >> 16) & 1u)) >> 16; }
__device__ __forceinline__ unsigned pk2(float lo, float hi) { return f2bf(lo) | (f2bf(hi) << 16); }
__device__ __forceinline__ float bf2f(unsigned short b) { return __builtin_bit_cast(float, (unsigned)b << 16); }
__device__ __forceinline__ float bflo(unsigned w) { return __builtin_bit_cast(float, w << 16); }
__device__ __forceinline__ float bfhi(unsigned w) { return __builtin_bit_cast(float, w & 0xffff0000u); }
__device__ __forceinline__ float bperm(float v, int srclane) { return __builtin_bit_cast(float, __builtin_amdgcn_ds_bpermute(srclane << 2, __builtin_bit_cast(int, v))); }
__device__ __forceinline__ float dpp_rotr1(float v) { return __builtin_bit_cast(float, __builtin_amdgcn_update_dpp(0, __builtin_bit_cast(int, v), 0x121, 0xf, 0xf, true)); }
__device__ __forceinline__ float dpp_rotl1(float v) { return __builtin_bit_cast(float, __builtin_amdgcn_update_dpp(0, __builtin_bit_cast(int, v), 0x12F, 0xf, 0xf, true)); }
__device__ __forceinline__ float dpp_shr1(float edge, float v) { return __builtin_bit_cast(float, __builtin_amdgcn_update_dpp(__builtin_bit_cast(int, edge), __builtin_bit_cast(int, v), 0x111, 0xf, 0xf, false)); }
__device__ __forceinline__ float dpp_shl1(float edge, float v) { return __builtin_bit_cast(float, __builtin_amdgcn_update_dpp(__builtin_bit_cast(int, edge), __builtin_bit_cast(int, v), 0x101, 0xf, 0xf, false)); }
__device__ __forceinline__ float wave_sum(float v, int lane) {
#pragma unroll
    for (int o = 1; o < 64; o <<= 1) v += bperm(v, lane ^ o);
    return v;
}
__device__ __forceinline__ int ltid() { int t = threadIdx.x; asm volatile("" : "+v"(t)); return t; }
__device__ __forceinline__ int lbid() { int b = blockIdx.x; asm volatile("" : "+s"(b)); return b; }
__device__ __forceinline__ int lgrid() { int g = gridDim.x; asm volatile("" : "+s"(g)); return g; }
__device__ __forceinline__ float sigmoidf_(float x) { return __builtin_amdgcn_rcpf(1.0f + __builtin_amdgcn_exp2f(x * -1.4426950408889634f)); }
__device__ __forceinline__ float gelu_tanh(float x) { const float u = 0.7978845608028654f * (x + 0.044715f * x * x * x); return x * sigmoidf_(2.0f * u); }

namespace pg8 {
constexpr int BM = 256, BK = 64, HALF = 128, HTB = HALF * BK * 2, STAGE_BYTES = 8 * HTB, NXCD = 8, WGM = 8;
__host__ __device__ __forceinline__ int lds_byte(int r, int c) { const int st = (r >> 4) * 2 + (c >> 5), rr = r & 15, cc = c & 31, ob = rr * 64 + cc * 2; return st * 1024 + (ob ^ (((ob >> 9) & 1) << 5)); }
__host__ __device__ __forceinline__ void stage_rc(int b, int& R, int& C) { const int st = b / 1024, sb = b % 1024, swz = sb ^ (((sb >> 9) & 1) << 5); R = (st >> 1) * 16 + swz / 64; C = (st & 1) * 32 + (swz % 64) / 2; }
__host__ __device__ __forceinline__ int perm32(int rho) { const int n = rho >> 4, i = rho & 15; return 8 * (i >> 2) + 4 * n + (i & 3); }

struct Unit { int pm, pn, g; };
struct Gemm { const char* A; const char* B; int nt; int a_row, a_seg; size_t a_kstep, a_g; int ldb; size_t b_g; };
struct Sched {
    int nM, nN, ng, G, c;
    __device__ __forceinline__ bool next(int i, Unit& u) const {
        const long L = (long)i * G + c; const int per = nM * nN; if (L >= (long)per * ng) return false;
        if (ng == 1) {
            int wgid = (int)L; { const int q = per / NXCD, r = per % NXCD, xcd = wgid % NXCD, off = wgid / NXCD; wgid = (xcd < r ? xcd * (q + 1) : r * (q + 1) + (xcd - r) * q) + off; }
            const int nig = WGM * nN, gid = wgid / nig, fm = gid * WGM, gsz = (nM - fm) < WGM ? (nM - fm) : WGM;
            u.pm = fm + ((wgid % nig) % gsz); u.pn = (wgid % nig) / gsz; u.g = 0;
        } else { u.g = (int)(L / per); const int r = (int)(L - (long)u.g * per); u.pm = r % nM; u.pn = r / nM; }
        return true;
    }
};
__device__ __forceinline__ unsigned cvt_pk_bf16(float lo, float hi) { unsigned r; asm volatile("v_cvt_pk_bf16_f32 %0, %1, %2" : "=v"(r) : "v"(lo), "v"(hi)); return r; }

constexpr int NBIAS = 27136;
__device__ __forceinline__ void apply_rstd_bias(f32x4 (&acc)[2][2][4][2], const float* ss, const float* bias, int rowt, int colt, bool perm, int wr, int wc, int fr, int fq, int bstride = NBIAS) {
    const int b = rowt / SEQ; const float* bp = bias + (size_t)b * bstride + colt + wc * 32 + (perm ? 8 * fq : 4 * fq);
    float rs[2][4];
#pragma unroll
    for (int ai = 0; ai < 2; ++ai)
#pragma unroll
        for (int m = 0; m < 4; ++m) rs[ai][m] = __builtin_amdgcn_rsqf(ss[rowt + ai * HALF + wr * 64 + m * 16 + fr] * (1.0f / DM) + EPS);
#pragma unroll
    for (int bj = 0; bj < 2; ++bj)
#pragma unroll
        for (int n = 0; n < 2; ++n) { const f32x4 bv = *(const f32x4*)(bp + bj * HALF + (perm ? 4 * n : 16 * n));
#pragma unroll
            for (int ai = 0; ai < 2; ++ai)
#pragma unroll
                for (int m = 0; m < 4; ++m) acc[ai][bj][m][n] = acc[ai][bj][m][n] * rs[ai][m] + bv; }
}
struct EpiBf16 {
    static constexpr bool PERM = true;
    bf16_t* O; int ldc; const float* ss; const float* bias; int bstride;
    __device__ __forceinline__ void operator()(f32x4 (&acc)[2][2][4][2], const Unit& u, int wr, int wc, int fr, int fq) const {
        apply_rstd_bias(acc, ss, bias, u.pm * BM, u.pn * BM, true, wr, wc, fr, fq, bstride);
        asm volatile("" ::: "memory"); __builtin_amdgcn_sched_barrier(0);
        const int row0 = u.pm * BM + wr * 64 + fr; const int col0 = u.pn * BM + wc * 32 + 8 * fq;
#pragma unroll
        for (int ai = 0; ai < 2; ++ai)
#pragma unroll
            for (int m = 0; m < 4; ++m) { bf16_t* rowp = O + (size_t)(row0 + ai * HALF + m * 16) * ldc + col0;
#pragma unroll
                for (int bj = 0; bj < 2; ++bj) { const f32x4 v0 = acc[ai][bj][m][0], v1 = acc[ai][bj][m][1];
                    u32x4 w; w.x = cvt_pk_bf16(v0[0], v0[1]); w.y = cvt_pk_bf16(v0[2], v0[3]); w.z = cvt_pk_bf16(v1[0], v1[1]); w.w = cvt_pk_bf16(v1[2], v1[3]);
                    *(u32x4*)(rowp + bj * HALF) = w; } }
    }
};
struct EpiBf16T {
    static constexpr bool PERM = true;
    bf16_t* O; const float* ss; const float* bias;
    __device__ __forceinline__ void operator()(f32x4 (&acc)[2][2][4][2], const Unit& u, int wr, int wc, int fr_, int fq_) const {
        int fr = fr_, fq = fq_; asm volatile("" : "+v"(fr), "+v"(fq));
        const int tok0 = u.pn * BM + wc * 32 + 8 * fq; const int b = (u.pn * BM) / SEQ; const float* bp = bias + (size_t)b * NBIAS;
        f32x4 rs[2][2];
#pragma unroll
        for (int bj = 0; bj < 2; ++bj)
#pragma unroll
            for (int n = 0; n < 2; ++n) { const f32x4 sv = *(const f32x4*)(ss + tok0 + bj * HALF + 4 * n);
#pragma unroll
                for (int e = 0; e < 4; ++e) rs[bj][n][e] = __builtin_amdgcn_rsqf(sv[e] * (1.0f / DM) + EPS); }
#pragma unroll
        for (int ai = 0; ai < 2; ++ai)
#pragma unroll
            for (int m = 0; m < 4; ++m) { const int c = u.pm * BM + ai * HALF + wr * 64 + m * 16 + fr; const float bv = bp[c];
#pragma unroll
                for (int bj = 0; bj < 2; ++bj) { const f32x4 v0 = acc[ai][bj][m][0] * rs[bj][0] + bv, v1 = acc[ai][bj][m][1] * rs[bj][1] + bv;
                    *(u32x4*)(O + (size_t)c * TOK + tok0 + bj * HALF) = (u32x4){cvt_pk_bf16(v0[0], v0[1]), cvt_pk_bf16(v0[2], v0[3]), cvt_pk_bf16(v1[0], v1[1]), cvt_pk_bf16(v1[2], v1[3])}; } }
    }
};
struct EpiQkv {
    static constexpr bool PERM = true;
    bf16_t* Qn; bf16_t* Kn; bf16_t* Vc; const float* ss; const float* bias; int bstride; const float* qg; const float* kg; const f32x2* rope; LAS float* xch0; LAS float* xch1;
    __device__ __forceinline__ void operator()(f32x4 (&acc)[2][2][4][2], const Unit& u, int wr, int wc, int fr_, int fq_) const {
        int fr = fr_, fq = fq_; asm volatile("" : "+v"(fr), "+v"(fq));
        apply_rstd_bias(acc, ss, bias, u.pm * BM, u.pn * BM, true, wr, wc, fr, fq, bstride);
        asm volatile("" ::: "memory"); __builtin_amdgcn_sched_barrier(0);
        const int lane = fq * 16 + fr; const int cw = wc * 32 + 8 * fq;
        if (u.pn == 5) {
#pragma unroll
            for (int ai = 0; ai < 2; ++ai)
#pragma unroll
                for (int m = 0; m < 4; ++m) { const int r = u.pm * BM + ai * HALF + wr * 64 + m * 16 + fr;
#pragma unroll
                    for (int bj = 0; bj < 2; ++bj) { const f32x4 v0 = acc[ai][bj][m][0], v1 = acc[ai][bj][m][1];
                        *(u32x4*)(Vc + (size_t)r * 256 + bj * HALF + cw) = (u32x4){cvt_pk_bf16(v0[0], v0[1]), cvt_pk_bf16(v0[2], v0[3]), cvt_pk_bf16(v1[0], v1[1]), cvt_pk_bf16(v1[2], v1[3])}; } }
            return;
        }
#pragma unroll
        for (int ai = 0; ai < 2; ++ai)
#pragma unroll
            for (int m = 0; m < 4; ++m)
#pragma unroll
                for (int bj = 0; bj < 2; ++bj) { const f32x4 v0 = acc[ai][bj][m][0], v1 = acc[ai][bj][m][1];
                    float sq = (v0.x * v0.x + v0.y * v0.y) + (v0.z * v0.z + v0.w * v0.w) + (v1.x * v1.x + v1.y * v1.y) + (v1.z * v1.z + v1.w * v1.w);
                    sq += bperm(sq, lane ^ 16); sq += bperm(sq, lane ^ 32);
                    if (fq == 0) (bj ? xch1 : xch0)[(ai * HALF + wr * 64 + m * 16 + fr) * 4 + wc] = sq; }
        asm volatile("s_waitcnt lgkmcnt(0)" ::: "memory"); __builtin_amdgcn_s_barrier(); asm volatile("" ::: "memory");
        const bool isq = (u.pn < 4); const float* gp = (isq ? qg : kg) + (wc & 1) * 32 + 8 * fq;
        const f32x4 g0 = *(const f32x4*)gp, g1 = *(const f32x4*)(gp + 4);
        const float C2 = isq ? 0.125f * 1.4426950408889634f : 1.0f;
        const int pi0 = (wc & 1) * 16 + 4 * fq;
#pragma unroll
        for (int ai = 0; ai < 2; ++ai)
#pragma unroll
            for (int m = 0; m < 4; ++m) { const int rt = ai * HALF + wr * 64 + m * 16 + fr; const int r = u.pm * BM + rt; const int t = r & (SEQ - 1);
                const f32x4 cs0 = *(const f32x4*)(rope + (size_t)t * 32 + pi0), cs1 = *(const f32x4*)(rope + (size_t)t * 32 + pi0 + 2);
#pragma unroll
                for (int bj = 0; bj < 2; ++bj) { LAS float* xc = bj ? xch1 : xch0;
                    const float tot = xc[rt * 4 + wc] + xc[rt * 4 + (wc ^ 1)];
                    const float rs = __builtin_amdgcn_rsqf(tot * (1.0f / 64.0f) + EPS) * C2;
                    const f32x4 v0 = acc[ai][bj][m][0] * g0 * rs, v1 = acc[ai][bj][m][1] * g1 * rs;
                    const float o0 = v0.x * cs0.x - v0.y * cs0.y, o1 = v0.x * cs0.y + v0.y * cs0.x, o2 = v0.z * cs0.z - v0.w * cs0.w, o3 = v0.z * cs0.w + v0.w * cs0.z;
                    const float o4 = v1.x * cs1.x - v1.y * cs1.y, o5 = v1.x * cs1.y + v1.y * cs1.x, o6 = v1.z * cs1.z - v1.w * cs1.w, o7 = v1.z * cs1.w + v1.w * cs1.z;
                    const u32x4 w = {cvt_pk_bf16(o0, o1), cvt_pk_bf16(o2, o3), cvt_pk_bf16(o4, o5), cvt_pk_bf16(o6, o7)};
                    if (isq) *(u32x4*)(Qn + (size_t)r * 1024 + u.pn * BM + bj * HALF + cw) = w; else *(u32x4*)(Kn + (size_t)r * 256 + bj * HALF + cw) = w; }
                asm volatile("" ::: "memory"); }
    }
};
__device__ __forceinline__ float shfl_xor_l(float v, int mask, int lane) { return bperm(v, lane ^ mask); }
struct NextNorm { bf16_t* Hn; const float* gn; const float* scn; float* ssn; };
struct EpiRes {
    static constexpr bool PERM = true;
    float* X; const float* gate; int rowoff; NextNorm nn; const float* Xr;
    __device__ __forceinline__ void operator()(f32x4 (&acc)[2][2][4][2], const Unit& u, int wr, int wc, int fr, int fq) const {
        const int rbase = rowoff + u.pm * BM; const int b = rbase / SEQ; const float* gp = gate + (size_t)b * 6144;
        const int row0 = rbase + wr * 64 + fr, col0 = u.pn * BM + wc * 32 + 8 * fq;
#pragma unroll
        for (int ai = 0; ai < 2; ++ai)
#pragma unroll
            for (int mh = 0; mh < 2; ++mh) {
                f32x4 xv[2][2][2], gv[2][2];
#pragma unroll
                for (int mm = 0; mm < 2; ++mm) { const float* p = Xr + (size_t)(row0 + ai * HALF + (2 * mh + mm) * 16) * DM + col0;
#pragma unroll
                    for (int bj = 0; bj < 2; ++bj)
#pragma unroll
                        for (int n = 0; n < 2; ++n) xv[mm][bj][n] = *(const f32x4*)(p + bj * HALF + n * 4); }
#pragma unroll
                for (int bj = 0; bj < 2; ++bj)
#pragma unroll
                    for (int n = 0; n < 2; ++n) gv[bj][n] = *(const f32x4*)(gp + col0 + bj * HALF + n * 4);
                float sq[2] = {0.f, 0.f};
#pragma unroll
                for (int mm = 0; mm < 2; ++mm) { const int r = row0 + ai * HALF + (2 * mh + mm) * 16; float* p = X + (size_t)r * DM + col0;
#pragma unroll
                    for (int bj = 0; bj < 2; ++bj)
#pragma unroll
                        for (int n = 0; n < 2; ++n) { const f32x4 xn = xv[mm][bj][n] + gv[bj][n] * acc[ai][bj][2 * mh + mm][n]; *(f32x4*)(p + bj * HALF + n * 4) = xn; xv[mm][bj][n] = xn;
                            sq[mm] += (xn.x * xn.x + xn.y * xn.y) + (xn.z * xn.z + xn.w * xn.w); } }
                if (nn.ssn) {
#pragma unroll
                    for (int mm = 0; mm < 2; ++mm) { const int r = row0 + ai * HALF + (2 * mh + mm) * 16; float q = sq[mm]; q += shfl_xor_l(q, 16, fq * 16 + fr); q += shfl_xor_l(q, 32, fq * 16 + fr); if (fq == 0) atomicAdd(nn.ssn + r, q); }
                    if (nn.Hn) {
#pragma unroll
                        for (int bj = 0; bj < 2; ++bj) { const float* gq = nn.gn + col0 + bj * HALF; const float* sp = nn.scn + (size_t)b * 6144 + col0 + bj * HALF;
                            const f32x4 c0 = *(const f32x4*)gq * (*(const f32x4*)sp + 1.0f), c1 = *(const f32x4*)(gq + 4) * (*(const f32x4*)(sp + 4) + 1.0f);
#pragma unroll
                            for (int mm = 0; mm < 2; ++mm) { const int r = row0 + ai * HALF + (2 * mh + mm) * 16; const f32x4 h0 = xv[mm][bj][0] * c0, h1 = xv[mm][bj][1] * c1;
                                *(u32x4*)(nn.Hn + (size_t)r * DM + col0 + bj * HALF) = (u32x4){cvt_pk_bf16(h0.x, h0.y), cvt_pk_bf16(h0.z, h0.w), cvt_pk_bf16(h1.x, h1.y), cvt_pk_bf16(h1.z, h1.w)}; } } } }
                asm volatile("" ::: "memory"); }
    }
};
struct EpiGlu {
    static constexpr bool PERM = true;
    float* X; const float* gate; NextNorm nn;
    __device__ __forceinline__ void operator()(f32x4 (&acc)[2][2][4][2], const Unit& u, int wr, int wc, int fr, int fq) const {
        const int rbase = u.pm * BM; const int b = rbase / SEQ; const float* gp = gate + (size_t)b * 6144;
        const int row0 = rbase + wr * 64 + fr, col0 = u.pn * HALF + wc * 32 + 8 * fq;
        f32x4 gv[2], cs[2];
#pragma unroll
        for (int n = 0; n < 2; ++n) { gv[n] = *(const f32x4*)(gp + col0 + n * 4); cs[n] = *(const f32x4*)(nn.gn + col0 + n * 4) * (*(const f32x4*)(nn.scn + (size_t)b * 6144 + col0 + n * 4) + 1.0f); }
#pragma unroll
        for (int ai = 0; ai < 2; ++ai) {
            f32x4 xv[4][2];
#pragma unroll
            for (int m = 0; m < 4; ++m) { const float* p = X + (size_t)(row0 + ai * HALF + m * 16) * DM + col0;
#pragma unroll
                for (int n = 0; n < 2; ++n) xv[m][n] = *(const f32x4*)(p + n * 4); }
#pragma unroll
            for (int m = 0; m < 4; ++m) { const int r = row0 + ai * HALF + m * 16; float* p = X + (size_t)r * DM + col0; float sq = 0.f; f32x4 hv[2];
#pragma unroll
                for (int n = 0; n < 2; ++n) { f32x4 x4 = xv[m][n]; const f32x4 ga = acc[ai][0][m][n], gb = acc[ai][1][m][n];
#pragma unroll
                    for (int e = 0; e < 4; ++e) x4[e] += gv[n][e] * ga[e] * sigmoidf_(gb[e]);
                    *(f32x4*)(p + n * 4) = x4; sq += (x4.x * x4.x + x4.y * x4.y) + (x4.z * x4.z + x4.w * x4.w); hv[n] = x4 * cs[n]; }
                *(u32x4*)(nn.Hn + (size_t)r * DM + col0) = (u32x4){cvt_pk_bf16(hv[0].x, hv[0].y), cvt_pk_bf16(hv[0].z, hv[0].w), cvt_pk_bf16(hv[1].x, hv[1].y), cvt_pk_bf16(hv[1].z, hv[1].w)};
                sq += shfl_xor_l(sq, 16, fq * 16 + fr); sq += shfl_xor_l(sq, 32, fq * 16 + fr); if (fq == 0) atomicAdd(nn.ssn + r, sq); }
            asm volatile("" ::: "memory"); }
    }
};
struct EpiS1 {
    static constexpr bool PERM = true;
    bf16_t* Yi; float* S;
    __device__ __forceinline__ void operator()(f32x4 (&acc)[2][2][4][2], const Unit& u, int wr, int wc, int fr, int fq) const {
        const int row0 = u.pm * BM + wr * 64 + fr; const int cw = wc * 32 + 8 * fq;
#pragma unroll
        for (int ai = 0; ai < 2; ++ai)
#pragma unroll
            for (int m = 0; m < 4; ++m) { const int r = row0 + ai * HALF + m * 16;
#pragma unroll
                for (int bj = 0; bj < 2; ++bj) { const f32x4 v0 = acc[ai][bj][m][0], v1 = acc[ai][bj][m][1]; const int c = u.pn * BM + bj * HALF + cw;
                    if (u.pn < 2) { u32x4 w; w.x = cvt_pk_bf16(v0[0], v0[1]); w.y = cvt_pk_bf16(v0[2], v0[3]); w.z = cvt_pk_bf16(v1[0], v1[1]); w.w = cvt_pk_bf16(v1[2], v1[3]);
                        *(u32x4*)(Yi + ((size_t)(r * 32 + (c >> 4)) * DM + u.g * 16 + (c & 15))) = w; }
                    else { float* sp = S + ((size_t)(u.g * 1024 + r) * 256 + (c - 512)); *(f32x4*)sp = v0; *(f32x4*)(sp + 4) = v1; } } }
    }
};
struct EpiS2 {
    static constexpr bool PERM = true;
    bf16_t* Yi;
    __device__ __forceinline__ void operator()(f32x4 (&acc)[2][2][4][2], const Unit& u, int wr, int wc, int fr, int fq) const {
        const int row0 = u.pm * BM + wr * 64 + fr; const int cw = wc * 32 + 8 * fq;
#pragma unroll
        for (int ai = 0; ai < 2; ++ai) {
            u32x4 yv[4][2];
#pragma unroll
            for (int m = 0; m < 4; ++m)
#pragma unroll
                for (int bj = 0; bj < 2; ++bj) { const int r = row0 + ai * HALF + m * 16, c = u.pn * BM + bj * HALF + cw; yv[m][bj] = *(const u32x4*)(Yi + ((size_t)(r * 32 + (c >> 4)) * DM + u.g * 16 + (c & 15))); }
#pragma unroll
            for (int m = 0; m < 4; ++m)
#pragma unroll
                for (int bj = 0; bj < 2; ++bj) { const int r = row0 + ai * HALF + m * 16, c = u.pn * BM + bj * HALF + cw; const f32x4 v0 = acc[ai][bj][m][0], v1 = acc[ai][bj][m][1]; const u32x4 yi = yv[m][bj];
                    u32x4 w;
                    w.x = cvt_pk_bf16(gelu_tanh(v0[0] + bflo(yi.x)), gelu_tanh(v0[1] + bfhi(yi.x)));
                    w.y = cvt_pk_bf16(gelu_tanh(v0[2] + bflo(yi.y)), gelu_tanh(v0[3] + bfhi(yi.y)));
                    w.z = cvt_pk_bf16(gelu_tanh(v1[0] + bflo(yi.z)), gelu_tanh(v1[1] + bfhi(yi.z)));
                    w.w = cvt_pk_bf16(gelu_tanh(v1[2] + bflo(yi.w)), gelu_tanh(v1[3] + bfhi(yi.w)));
                    *(u32x4*)(Yi + ((size_t)(r * 32 + (c >> 4)) * DM + u.g * 16 + (c & 15))) = w; }
            asm volatile("" ::: "memory"); }
    }
};

struct EpiFfn {
    static constexpr bool PERM = true;
    bf16_t* G; float* halo; const float* cw; const float* cb; LAS float* edge; const float* ss; const float* bias;
    __device__ __forceinline__ void operator()(f32x4 (&acc)[2][2][4][2], const Unit& u, int wr, int wc, int fr, int fq) const {
        apply_rstd_bias(acc, ss, bias, u.pm * BM, u.pn * BM, true, wr, wc, fr, fq);
        asm volatile("" ::: "memory"); __builtin_amdgcn_sched_barrier(0);
        const int lane = fq * 16 + fr; const int cl = wc * 32 + 8 * fq;
        const int col0 = u.pn * HALF + cl;
        if (fr == 0) {
#pragma unroll
            for (int ai = 0; ai < 2; ++ai) { *(LAS f32x4*)(edge + ((wr * 2 + ai) * 2 + 0) * 128 + cl) = acc[ai][0][0][0]; *(LAS f32x4*)(edge + ((wr * 2 + ai) * 2 + 0) * 128 + cl + 4) = acc[ai][0][0][1]; } }
        if (fr == 15) {
#pragma unroll
            for (int ai = 0; ai < 2; ++ai) { *(LAS f32x4*)(edge + ((wr * 2 + ai) * 2 + 1) * 128 + cl) = acc[ai][0][3][0]; *(LAS f32x4*)(edge + ((wr * 2 + ai) * 2 + 1) * 128 + cl + 4) = acc[ai][0][3][1]; } }
        { float* hp = halo + (size_t)u.pm * 6 * DFF + col0;
          if (wr == 0 && fr < 2) { *(f32x4*)(hp + fr * DFF) = acc[0][0][0][0]; *(f32x4*)(hp + fr * DFF + 4) = acc[0][0][0][1]; if (fr == 0) { *(f32x4*)(hp + 4 * DFF) = acc[0][1][0][0]; *(f32x4*)(hp + 4 * DFF + 4) = acc[0][1][0][1]; } }
          if (wr == 1 && fr >= 14) { *(f32x4*)(hp + (fr - 12) * DFF) = acc[1][0][3][0]; *(f32x4*)(hp + (fr - 12) * DFF + 4) = acc[1][0][3][1]; if (fr == 15) { *(f32x4*)(hp + 5 * DFF) = acc[1][1][3][0]; *(f32x4*)(hp + 5 * DFF + 4) = acc[1][1][3][1]; } } }
        asm volatile("s_waitcnt lgkmcnt(0)" ::: "memory"); __builtin_amdgcn_s_barrier(); asm volatile("" ::: "memory");
        const int srcR = (lane & 48) | ((fr + 15) & 15), srcL = (lane & 48) | ((fr + 1) & 15);
        const int ow = wr ^ 1;
        u32x2 stash[2][4];
#pragma unroll
        for (int n = 0; n < 2; ++n) {
            const int cc = col0 + 4 * n;
            const f32x4 w0 = *(const f32x4*)(cw + cc), w1 = *(const f32x4*)(cw + DFF + cc), w2 = *(const f32x4*)(cw + 2 * DFF + cc), bb = *(const f32x4*)(cb + cc);
#pragma unroll
            for (int ai = 0; ai < 2; ++ai) {
                const int pa = (wr == 0) ? ai - 1 : ai, na = (wr == 0) ? ai : ai + 1;
                const f32x4 eP = (pa >= 0) ? *(const LAS f32x4*)(edge + ((ow * 2 + pa) * 2 + 1) * 128 + cl + 4 * n) : (f32x4){0.f, 0.f, 0.f, 0.f};
                const f32x4 eN = (na <= 1) ? *(const LAS f32x4*)(edge + ((ow * 2 + na) * 2 + 0) * 128 + cl + 4 * n) : (f32x4){0.f, 0.f, 0.f, 0.f};
                f32x4 Rprev = eP;
#pragma unroll
                for (int m = 0; m < 4; ++m) {
                    const int rt = ai * HALF + wr * 64 + m * 16 + fr;
                    f32x4 Rm, Ln; float o[4];
#pragma unroll
                    for (int e = 0; e < 4; ++e) { Rm[e] = dpp_rotr1(acc[ai][0][m][n][e]); Ln[e] = (m < 3) ? dpp_rotl1(acc[ai][0][m < 3 ? m + 1 : 3][n][e]) : eN[e]; }
#pragma unroll
                    for (int e = 0; e < 4; ++e) {
                        const float cur = acc[ai][0][m][n][e];
                        const float pv = dpp_shr1(Rprev[e], cur), nv = dpp_shl1(Ln[e], cur);
                        const float gt = pv * w0[e] + cur * w1[e] + nv * w2[e] + bb[e];
                        o[e] = gt * sigmoidf_(gt) * acc[ai][1][m][n][e]; }
                    const u32x2 pkd = {cvt_pk_bf16(o[0], o[1]), cvt_pk_bf16(o[2], o[3])};
                    if (n == 0) stash[ai][m] = pkd;
                    else if (rt != 0 && rt != 255) *(u32x4*)(G + (size_t)(u.pm * BM + rt) * DFF + col0) = (u32x4){stash[ai][m].x, stash[ai][m].y, pkd.x, pkd.y};
                    Rprev = Rm; asm volatile("" ::: "memory");
                }
            }
        }
    }
};

template <class Epi>
__device__ __forceinline__ void gemm_phase(LAS unsigned char* lds, const Gemm g, const Sched& S, const Epi& E) {
    const int tid = ltid(), wid = __builtin_amdgcn_readfirstlane(tid >> 6), lane = tid & 63, wr = wid >> 2, wc = wid & 3, fr = lane & 15, fq = lane >> 4;
    int nt = g.nt; asm volatile("" : "+s"(nt));
    unsigned voffA[2], voffB[2];
#pragma unroll
    for (int i = 0; i < 2; ++i) { int R, C; stage_rc(tid * 16 + i * 8192, R, C); const int Rb = Epi::PERM ? ((R & ~31) + perm32(R & 31)) : R;
        voffA[i] = (unsigned)(R * g.a_row + (C >> 4) * g.a_seg + (C & 15)) * 2u; voffB[i] = (unsigned)(Rb * g.ldb + C) * 2u; }
    const size_t kA = g.a_kstep, kB = (size_t)(BK * 2);
    const size_t hA = (size_t)HALF * g.a_row * 2, hB = (size_t)HALF * g.ldb * 2, tA = 2 * hA, tB = 2 * hB;
    const unsigned ldsw = (unsigned)wid * 1024u;
    const int aoff = lds_byte(wr * 64 + fr, fq * 8), boff = lds_byte(wc * 32 + fr, fq * 8);
#define PG8_SA(b, h) (((b) * 2 + (h)) * HTB)
#define PG8_SB(b, h) ((4 + (b) * 2 + (h)) * HTB)
#define PG8_STAGE(bufoff, gbase, voff) do { _Pragma("unroll") for (int _i = 0; _i < 2; ++_i) \
        __builtin_amdgcn_global_load_lds((const unsigned*)((const char*)(gbase) + (voff)[_i]), (LAS unsigned*)(lds + (bufoff) + ldsw + _i * 8192), 16, 0, 0); } while (0)
#define PG8_LDA(dst, b, h) do { _Pragma("unroll") for (int m = 0; m < 4; ++m) _Pragma("unroll") for (int k = 0; k < 2; ++k) dst[m][k] = *(const LAS bf16x8*)(lds + PG8_SA(b, h) + aoff + m * 2048 + k * 1024); } while (0)
#define PG8_LDB(dst, b, h) do { _Pragma("unroll") for (int n = 0; n < 2; ++n) _Pragma("unroll") for (int k = 0; k < 2; ++k) dst[n][k] = *(const LAS bf16x8*)(lds + PG8_SB(b, h) + boff + n * 2048 + k * 1024); } while (0)
#define PG8_MMA(ai, bj, At, Bt) do { __builtin_amdgcn_s_setprio(1); _Pragma("unroll") for (int m = 0; m < 4; ++m) _Pragma("unroll") for (int n = 0; n < 2; ++n) _Pragma("unroll") for (int k = 0; k < 2; ++k) \
        acc[ai][bj][m][n] = __builtin_amdgcn_mfma_f32_16x16x32_bf16(Bt[n][k], At[m][k], acc[ai][bj][m][n], 0, 0, 0); __builtin_amdgcn_s_setprio(0); } while (0)
#define PG8_WAIT_V(n) asm volatile("s_waitcnt vmcnt(" #n ")" ::: "memory")
#define PG8_WAIT_L(n) asm volatile("s_waitcnt lgkmcnt(" #n ")" ::: "memory")
#define PG8_BAR __builtin_amdgcn_s_barrier()
#define PG8_SCHED __builtin_amdgcn_sched_barrier(0)
    Unit cur, nxt; int ui = 0;
    if (!S.next(0, cur)) return;
    f32x4 acc[2][2][4][2];
#pragma unroll
    for (int a = 0; a < 2; ++a)
#pragma unroll
        for (int b = 0; b < 2; ++b)
#pragma unroll
            for (int m = 0; m < 4; ++m)
#pragma unroll
                for (int n = 0; n < 2; ++n) acc[a][b][m][n] = (f32x4){0.f, 0.f, 0.f, 0.f};
    bf16x8 At[4][2], B0[2][2], B1[2][2];
    const char* cA = g.A + (size_t)cur.g * g.a_g + (size_t)cur.pm * tA; const char* cB = g.B + (size_t)cur.g * g.b_g + (size_t)cur.pn * tB;
    PG8_STAGE(PG8_SB(0, 0), cB, voffB); PG8_STAGE(PG8_SB(0, 1), cB + hB, voffB); PG8_STAGE(PG8_SA(0, 0), cA, voffA); PG8_STAGE(PG8_SA(0, 1), cA + hA, voffA);
    if (wr == 1) PG8_BAR;
    PG8_WAIT_V(2); PG8_BAR;
    PG8_STAGE(PG8_SB(1, 0), cB + kB, voffB); PG8_STAGE(PG8_SA(1, 0), cA + kA, voffA); PG8_STAGE(PG8_SB(1, 1), cB + hB + kB, voffB);
    PG8_WAIT_V(6); PG8_BAR;
    for (;;) {
        const bool has_next = S.next(ui + 1, nxt);
        const char* nA = has_next ? g.A + (size_t)nxt.g * g.a_g + (size_t)nxt.pm * tA : cA; const char* nB = has_next ? g.B + (size_t)nxt.g * g.b_g + (size_t)nxt.pn * tB : cB;
        for (int t = 0; t < nt; t += 2) {
            const bool last = (t == nt - 2);
            const char* a1 = cA + (size_t)(t + 1) * kA;
            const char* a2 = last ? nA : cA + (size_t)(t + 2) * kA; const char* b2 = last ? nB : cB + (size_t)(t + 2) * kB;
            const char* a3 = a2 + kA; const char* b3 = b2 + kB;
            PG8_LDB(B0, 0, 0); PG8_LDB(B1, 0, 1); PG8_SCHED; PG8_LDA(At, 0, 0); PG8_STAGE(PG8_SA(1, 1), a1 + hA, voffA);
            PG8_WAIT_V(8); PG8_WAIT_L(0); PG8_BAR; PG8_MMA(0, 0, At, B0); PG8_MMA(0, 1, At, B1); PG8_BAR; PG8_SCHED;
            PG8_LDA(At, 0, 1); PG8_STAGE(PG8_SB(0, 0), b2, voffB); PG8_STAGE(PG8_SB(0, 1), b2 + hB, voffB); PG8_STAGE(PG8_SA(0, 0), a2, voffA);
            PG8_WAIT_V(8); PG8_WAIT_L(0); PG8_BAR; PG8_MMA(1, 0, At, B0); PG8_MMA(1, 1, At, B1); PG8_BAR; PG8_SCHED;
            PG8_LDB(B0, 1, 0); PG8_LDB(B1, 1, 1); PG8_SCHED; PG8_LDA(At, 1, 0); PG8_STAGE(PG8_SA(0, 1), a2 + hA, voffA);
            PG8_WAIT_V(8); PG8_WAIT_L(0); PG8_BAR; PG8_MMA(0, 0, At, B0); PG8_MMA(0, 1, At, B1); PG8_BAR; PG8_SCHED;
            PG8_LDA(At, 1, 1); PG8_STAGE(PG8_SB(1, 0), b3, voffB); PG8_STAGE(PG8_SB(1, 1), b3 + hB, voffB); PG8_STAGE(PG8_SA(1, 0), a3, voffA);
            PG8_WAIT_V(8); PG8_WAIT_L(0); PG8_BAR; PG8_MMA(1, 0, At, B0); PG8_MMA(1, 1, At, B1); PG8_BAR; PG8_SCHED;
        }
        if (wr == 0) PG8_BAR;
        E(acc, cur, wr, wc, fr, fq);
        if (!has_next) break;
#pragma unroll
        for (int a = 0; a < 2; ++a)
#pragma unroll
            for (int b = 0; b < 2; ++b)
#pragma unroll
                for (int m = 0; m < 4; ++m)
#pragma unroll
                    for (int n = 0; n < 2; ++n) acc[a][b][m][n] = (f32x4){0.f, 0.f, 0.f, 0.f};
        cur = nxt; cA = nA; cB = nB; ++ui;
        if (wr == 1) PG8_BAR;
    }
    PG8_WAIT_V(0);
    PG8_BAR;
#undef PG8_SA
#undef PG8_SB
#undef PG8_STAGE
#undef PG8_LDA
#undef PG8_LDB
#undef PG8_MMA
#undef PG8_WAIT_V
#undef PG8_WAIT_L
#undef PG8_BAR
#undef PG8_SCHED
}
}
namespace attn_body {
using bf16=__hip_bfloat16;
using bf16x8=__attribute__((ext_vector_type(8)))short;
using s16x4=__attribute__((ext_vector_type(4)))short;
using f32x16=__attribute__((ext_vector_type(16)))float;
using u32x4=__attribute__((ext_vector_type(4)))unsigned;
constexpr int BATCH=4,NHEAD=16,SEQ=8192,D=64,DM=NHEAD*D,DMK=256;
constexpr int NW=8,QBLK=32,QB=QBLK*NW,KVBLK=64,NQB=SEQ/QB;
constexpr int ATTN_PITCH=DM, ATTN_UNIT_ROWS=QB;
__device__ __forceinline__ int crow(int r,int hi){return (r&3)+8*(r>>2)+4*hi;}
#define SBAR() __builtin_amdgcn_sched_barrier(0)
__device__ __forceinline__ void cmask(f32x16&p0,f32x16&p1,int jb,int qrel,int hi){
  const float NEG=-INFINITY; int kb=64*jb+4*hi;
  #pragma unroll
  for(int r=0;r<16;++r){int kv=kb+(r&3)+8*(r>>2); if(kv>qrel)p0[r]=NEG; if(kv+32>qrel)p1[r]=NEG;}
}

constexpr int NSLOT=3, SLOTB=8192;
constexpr int LDS_K=0, LDS_V=NSLOT*SLOTB, LDS_WS=2*NSLOT*SLOTB, LDS_OST=LDS_WS+NW*64*4, LDS_BYTES=LDS_OST+NW*4096;
constexpr float C2=0.125f*1.4426950408889634f;
__device__ __forceinline__ void glds16(const void*gsrc,unsigned lds_dst){unsigned keep;
  asm volatile("s_mov_b32 %0, m0\n\ts_mov_b32 m0, %2\n\ts_nop 0\n\tglobal_load_lds_dwordx4 %1, off\n\ts_mov_b32 m0, %0":"=&s"(keep):"v"(gsrc),"s"(lds_dst):"memory");}
__device__ __forceinline__ float max3f(float a,float b,float c){float r;asm("v_max3_f32 %0, %1, %2, %3":"=v"(r):"v"(a),"v"(b),"v"(c));return r;}
__device__ __forceinline__ float max2f(float a,float b){float r;asm("v_max_f32_e32 %0, %1, %2":"=v"(r):"v"(a),"v"(b));return r;}
__device__ __forceinline__ float fadd_s(float a,float b){float r;asm("v_add_f32_e32 %0, %1, %2":"=v"(r):"v"(a),"v"(b));return r;}
__device__ __forceinline__ float fsub_s(float a,float b){float r;asm("v_sub_f32_e32 %0, %1, %2":"=v"(r):"v"(a),"v"(b));return r;}
typedef float f32x2_t __attribute__((ext_vector_type(2))); typedef __bf16 bf16x2_t __attribute__((ext_vector_type(2)));
__device__ __forceinline__ unsigned cvtpk_s(float lo,float hi){f32x2_t v={lo,hi};bf16x2_t b=__builtin_convertvector(v,bf16x2_t);return __builtin_bit_cast(unsigned,b);}
#define WAIT_BAR(N) asm volatile("s_waitcnt vmcnt(" #N ") lgkmcnt(0)\n\ts_barrier":::"memory")

__device__ __forceinline__ void qkt(f32x16&p0,f32x16&p1,const char*Kslot,const bf16x8*qr,const f32x16&negm,int r32,int hi){
  const char*kb=Kslot+hi*1024+r32*16;
  #pragma unroll
  for(int d0=0;d0<4;++d0){
    const bf16x8 b0=*reinterpret_cast<const bf16x8*>(kb+d0*2048);
    const bf16x8 b1=*reinterpret_cast<const bf16x8*>(kb+d0*2048+512);
    if(d0==0){p0=__builtin_amdgcn_mfma_f32_32x32x16_bf16(b0,qr[0],negm,0,0,0);p1=__builtin_amdgcn_mfma_f32_32x32x16_bf16(b1,qr[0],negm,0,0,0);}
    else{p0=__builtin_amdgcn_mfma_f32_32x32x16_bf16(b0,qr[d0],p0,0,0,0);p1=__builtin_amdgcn_mfma_f32_32x32x16_bf16(b1,qr[d0],p1,0,0,0);}}
}
typedef __attribute__((address_space(3))) const char* lds_cptr;
typedef short v4i16_t __attribute__((ext_vector_type(4)));
__device__ __forceinline__ void kload8(bf16x8*kf,lds_cptr kp){
  kf[0]=*(const __attribute__((address_space(3))) bf16x8*)(kp);      kf[1]=*(const __attribute__((address_space(3))) bf16x8*)(kp+512);
  kf[2]=*(const __attribute__((address_space(3))) bf16x8*)(kp+2048); kf[3]=*(const __attribute__((address_space(3))) bf16x8*)(kp+2560);
  kf[4]=*(const __attribute__((address_space(3))) bf16x8*)(kp+4096); kf[5]=*(const __attribute__((address_space(3))) bf16x8*)(kp+4608);
  kf[6]=*(const __attribute__((address_space(3))) bf16x8*)(kp+6144); kf[7]=*(const __attribute__((address_space(3))) bf16x8*)(kp+6656);
}
__device__ __forceinline__ void kload2(bf16x8*kf,lds_cptr kp,int j){ kf[2*j]=*(const __attribute__((address_space(3))) bf16x8*)(kp+j*2048); kf[2*j+1]=*(const __attribute__((address_space(3))) bf16x8*)(kp+j*2048+512); }
__device__ __forceinline__ s16x4 vtr(lds_cptr p){ return __builtin_bit_cast(s16x4,__builtin_amdgcn_ds_read_tr16_b64_v4i16((__attribute__((address_space(3))) v4i16_t*)p)); }
__device__ __forceinline__ float rowmax(const f32x16&p0,const f32x16&p1){
  float a=max3f(p0[0],p0[1],p1[0]),b=max3f(p0[2],p0[3],p1[1]);a=max3f(a,p1[2],p1[3]);
  #pragma unroll
  for(int r=4;r<16;r+=4){a=max3f(a,p0[r],p0[r+1]);b=max3f(b,p0[r+2],p0[r+3]);a=max3f(a,p1[r],p1[r+1]);b=max3f(b,p1[r+2],p1[r+3]);}
  const float m=max2f(a,b);
  auto rr=__builtin_amdgcn_permlane32_swap(__float_as_uint(m),__float_as_uint(m),false,false);
  return max2f(__uint_as_float(rr[0]),__uint_as_float(rr[1]));
}
__device__ __forceinline__ void pv(f32x16*o,int vb,bf16x8 pa0,bf16x8 pa1,bf16x8 pa2,bf16x8 pa3){
  #pragma unroll
  for(int d0=0;d0<2;++d0){s16x4 lo[4],hi[4];
    #pragma unroll
    for(int ks=0;ks<4;++ks){
      asm volatile("ds_read_b64_tr_b16 %0,%1 offset:%c2":"=&v"(lo[ks]):"v"(vb),"i"(d0*4096+ks*1024):"memory");
      asm volatile("ds_read_b64_tr_b16 %0,%1 offset:%c2":"=&v"(hi[ks]):"v"(vb),"i"(d0*4096+ks*1024+512):"memory");}
    asm volatile("s_waitcnt lgkmcnt(0)":::"memory");SBAR();
    #define PK(k) (bf16x8){lo[k][0],lo[k][1],lo[k][2],lo[k][3],hi[k][0],hi[k][1],hi[k][2],hi[k][3]}
    o[d0]=__builtin_amdgcn_mfma_f32_32x32x16_bf16(pa0,PK(0),o[d0],0,0,0);
    o[d0]=__builtin_amdgcn_mfma_f32_32x32x16_bf16(pa1,PK(1),o[d0],0,0,0);
    o[d0]=__builtin_amdgcn_mfma_f32_32x32x16_bf16(pa2,PK(2),o[d0],0,0,0);
    o[d0]=__builtin_amdgcn_mfma_f32_32x32x16_bf16(pa3,PK(3),o[d0],0,0,0);
    #undef PK
  }
}

#ifndef ATTN_STORE16
#define ATTN_STORE16(p,v) (*(u32x4*)(p)=(v))
#endif
template<int THRL> __device__ __forceinline__ void attn_unit(int b,int h,int qb,const bf16*Q,const bf16*__restrict__ K,const bf16*__restrict__ V,bf16*O,char*shm){
  const int tid=ltid(),lane=tid&63,r32=lane&31,hi=lane>>5; const int wid=__builtin_amdgcn_readfirstlane(tid>>6);
  const long rowbase=(long)b*SEQ; const int q0=qb*QB;
  const bf16*Qw=Q+(rowbase+q0+wid*QBLK)*DM+h*D;
  const bf16*Kh=K+rowbase*DMK+(h>>2)*D,*Vh=V+rowbase*DMK+(h>>2)*D;
  const unsigned lds0=(unsigned)(uintptr_t)shm;
  float*wsf=(float*)(shm+LDS_WS)+wid*64;
  const bf16*ksrc=Kh+(long)lane*DMK+wid*8;
  const bf16*vsrc=Vh+(long)(16*(wid&3)+(lane>>2))*DMK+(wid>>2)*32+(lane&3)*8;
  const unsigned kdst=lds0+LDS_K+wid*1024, vdst=lds0+LDS_V+wid*1024;
  #define DMA_K(t,slot) glds16(ksrc+(long)(t)*KVBLK*DMK,(unsigned)__builtin_amdgcn_readfirstlane(kdst+(slot)))
  #define DMA_V(t,slot) glds16(vsrc+(long)(t)*KVBLK*DMK,(unsigned)__builtin_amdgcn_readfirstlane(vdst+(slot)))
  const int vb0=(int)(lds0+LDS_V)+((lane>>4)&1)*32+(lane&3)*8+(4*hi+((lane&15)>>2))*64;
  const char*Kbase=shm+LDS_K; bf16x8 kf[8];
  const lds_cptr shm3=(lds_cptr)shm; const lds_cptr kp0=shm3+LDS_K+hi*1024+r32*16; const lds_cptr vp0=shm3+LDS_V+((lane>>4)&1)*32+(lane&3)*8+(4*hi+((lane&15)>>2))*64;
  const int NT=SEQ/KVBLK;
  DMA_K(0,0);DMA_V(0,0);DMA_K(1,SLOTB);
  bf16x8 qr[4];
  #pragma unroll
  for(int d0=0;d0<4;++d0)qr[d0]=*reinterpret_cast<const bf16x8*>(&Qw[(long)r32*DM+d0*16+hi*8]);
  float mhat=0.f,l_reg=0.f;f32x16 o[2];o[0]=f32x16{};o[1]=f32x16{};f32x16 negm=f32x16{};asm volatile("":"+v"(negm));
  const int qrel=wid*QBLK+r32;
  #define CMASK(P0,P1,t) do{}while(0)
  bool resc=false;
  #define START(P0,P1) do{ const float rm=rowmax(P0,P1); resc=false; \
    { const float dl=rm; mhat=fadd_s(mhat,dl); \
      _Pragma("unroll") for(int r=0;r<16;++r){P0[r]=fsub_s(P0[r],dl);P1[r]=fsub_s(P1[r],dl);} \
      _Pragma("unroll") for(int r=0;r<16;++r)negm[r]=-mhat; asm volatile("":"+v"(negm)); } \
    _Pragma("unroll") for(int r=0;r<16;++r)P0[r]=__builtin_amdgcn_exp2f(P0[r]); }while(0)
  #define RESC() do{ if(resc){ asm volatile("s_waitcnt lgkmcnt(0)":::"memory"); \
      _Pragma("unroll") for(int d_=0;d_<2;++d_) _Pragma("unroll") for(int r=0;r<16;++r)o[d_][r]*=wsf[crow(r,hi)]; } }while(0)
  f32x16 pA0,pA1,pB0,pB1;
  int sl_prev=0,sl_cur=0,sl_next=SLOTB;
  #define ROT() do{sl_prev=sl_cur;sl_cur=sl_next;sl_next=(sl_next==(NSLOT-1)*SLOTB)?0:sl_next+SLOTB;}while(0)
  DMA_K(2,2*SLOTB);
  WAIT_BAR(3);
  qkt(pA0,pA1,Kbase,qr,negm,r32,hi);asm volatile("s_nop 15\n\ts_nop 7":"+v"(pA0),"+v"(pA1));CMASK(pA0,pA1,0);
  START(pA0,pA1);
  _Pragma("unroll") for(int r=0;r<16;++r)pA1[r]=__builtin_amdgcn_exp2f(pA1[r]);
  WAIT_BAR(0);
  DMA_K(3,0);DMA_V(1,SLOTB);
  ROT();
  kload8(kf,kp0+sl_cur);
  WAIT_BAR(2);
  s16x4 vlo[8],vhi[8]; u32x4 pw0,pw1,pw2,pw3;
  #define PKW(P,B) cvtpk_s(P[B],P[B+1])
  #define PAF(k) __builtin_bit_cast(bf16x8,pw##k)
  #define VFR(i) (bf16x8){vlo[i][0],vlo[i][1],vlo[i][2],vlo[i][3],vhi[i][0],vhi[i][1],vhi[i][2],vhi[i][3]}
  #define PIN(x) asm volatile("":"+v"(x))
  #define MX3(a,b,c) __builtin_fmaxf(__builtin_fmaxf((a),(b)),(c))
  #define GAPA(MF,A0,A1,A2,A3,W0,W1,PW) do{ MF; sacc+=A0; sacc+=A1; sacc+=A2; sacc+=A3; PIN(sacc); W0; W1; PIN(PW); SBAR(); }while(0)
  #define EX(v) __builtin_amdgcn_exp2f(v)
  #define GAPB(MF,X,B) do{ MF; X[B]=EX(X[B]); X[B+1]=EX(X[B+1]); X[B+2]=EX(X[B+2]); X[B+3]=EX(X[B+3]); PIN(X); SBAR(); }while(0)
  #define VRD(i) do{ vlo[i]=vtr(vp_+(((i)>>2)*4096+((i)&3)*1024)); vhi[i]=vtr(vp_+(((i)>>2)*4096+((i)&3)*1024+512)); }while(0)
  #define KRD(G,j) do{ if(G){ kload2(kf,kp0+sl_next,j); SBAR(); } }while(0)
  #define STEP(C0,C1,P0,P1,t,GK,GV,GL) do{ SBAR(); \
    const lds_cptr vp_=vp0+sl_prev; \
    VRD(0); SBAR(); float sacc=(P0[0]+P0[1]); \
    GAPA(C0=__builtin_amdgcn_mfma_f32_32x32x16_bf16(kf[0],qr[0],negm,0,0,0), P0[2],P0[3],P0[4],P0[5],     pw0[0]=PKW(P0,0), pw0[1]=PKW(P0,2), pw0); \
    VRD(4); SBAR(); GAPA(C1=__builtin_amdgcn_mfma_f32_32x32x16_bf16(kf[1],qr[0],negm,0,0,0), P0[6],P0[7],P0[8],P0[9],     pw0[2]=PKW(P0,4), pw0[3]=PKW(P0,6), pw0); \
    VRD(1); SBAR(); GAPA(C0=__builtin_amdgcn_mfma_f32_32x32x16_bf16(kf[2],qr[1],C0,0,0,0),   P0[10],P0[11],P0[12],P0[13], pw1[0]=PKW(P0,8), pw1[1]=PKW(P0,10), pw1); \
    VRD(5); SBAR(); GAPA(C1=__builtin_amdgcn_mfma_f32_32x32x16_bf16(kf[3],qr[1],C1,0,0,0),   P0[14],P0[15],P1[0],P1[1],   pw1[2]=PKW(P0,12),pw1[3]=PKW(P0,14), pw1); \
    VRD(2); SBAR(); GAPA(C0=__builtin_amdgcn_mfma_f32_32x32x16_bf16(kf[4],qr[2],C0,0,0,0),   P1[2],P1[3],P1[4],P1[5],     pw2[0]=PKW(P1,0), pw2[1]=PKW(P1,2), pw2); \
    VRD(6); SBAR(); GAPA(C1=__builtin_amdgcn_mfma_f32_32x32x16_bf16(kf[5],qr[2],C1,0,0,0),   P1[6],P1[7],P1[8],P1[9],     pw2[2]=PKW(P1,4), pw2[3]=PKW(P1,6), pw2); \
    VRD(3); SBAR(); GAPA(C0=__builtin_amdgcn_mfma_f32_32x32x16_bf16(kf[6],qr[3],C0,0,0,0),   P1[10],P1[11],P1[12],P1[13], pw3[0]=PKW(P1,8), pw3[1]=PKW(P1,10), pw3); \
    VRD(7); SBAR(); GAPA(C1=__builtin_amdgcn_mfma_f32_32x32x16_bf16(kf[7],qr[3],C1,0,0,0),   P1[14],P1[15],0.f,0.f,       pw3[2]=PKW(P1,12),pw3[3]=PKW(P1,14), pw3); \
    l_reg+=sacc; \
    if(GK){DMA_K((t)+3,sl_cur);} if(GV){DMA_V((t)+1,sl_next);} \
    CMASK(C0,C1,t); \
    { float a=MX3(C0[0],C0[1],C1[0]),b=MX3(C0[2],C0[3],C1[1]); a=MX3(a,C1[2],C1[3]); \
      _Pragma("unroll") for(int r=4;r<16;r+=4){a=MX3(a,C0[r],C0[r+1]);b=MX3(b,C0[r+2],C0[r+3]);a=MX3(a,C1[r],C1[r+1]);b=MX3(b,C1[r+2],C1[r+3]);} \
      float rm=__builtin_fmaxf(a,b); { auto rr=__builtin_amdgcn_permlane32_swap(__float_as_uint(rm),__float_as_uint(rm),false,false); rm=__builtin_fmaxf(__uint_as_float(rr[0]),__uint_as_float(rr[1])); } \
      resc=false; \
      if(__builtin_expect(__any(rm>(float)THRL),0)){ const float dl=__builtin_fmaxf(rm,0.f); mhat+=dl; \
        _Pragma("unroll") for(int r=0;r<16;++r){C0[r]-=dl;C1[r]-=dl;} \
        _Pragma("unroll") for(int r=0;r<16;++r)negm[r]=-mhat; asm volatile("":"+v"(negm)); \
        const float f=__builtin_amdgcn_exp2f(-dl); l_reg*=f; if(hi==0)wsf[r32]=f; resc=true; } } \
    SBAR(); \
    GAPB(o[0]=__builtin_amdgcn_mfma_f32_32x32x16_bf16(PAF(0),VFR(0),o[0],0,0,0), C0,0); \
    GAPB(o[1]=__builtin_amdgcn_mfma_f32_32x32x16_bf16(PAF(0),VFR(4),o[1],0,0,0), C0,4); \
    KRD(GL,0); GAPB(o[0]=__builtin_amdgcn_mfma_f32_32x32x16_bf16(PAF(1),VFR(1),o[0],0,0,0), C0,8); \
    KRD(GL,1); GAPB(o[1]=__builtin_amdgcn_mfma_f32_32x32x16_bf16(PAF(1),VFR(5),o[1],0,0,0), C0,12); \
    KRD(GL,2); GAPB(o[0]=__builtin_amdgcn_mfma_f32_32x32x16_bf16(PAF(2),VFR(2),o[0],0,0,0), C1,0); \
    KRD(GL,3); GAPB(o[1]=__builtin_amdgcn_mfma_f32_32x32x16_bf16(PAF(2),VFR(6),o[1],0,0,0), C1,4); \
    GAPB(o[0]=__builtin_amdgcn_mfma_f32_32x32x16_bf16(PAF(3),VFR(3),o[0],0,0,0), C1,8); \
    GAPB(o[1]=__builtin_amdgcn_mfma_f32_32x32x16_bf16(PAF(3),VFR(7),o[1],0,0,0), C1,12); \
    }while(0)
  int t=1;
  #undef CMASK
  #define CMASK(P0,P1,t) do{}while(0)
  for(;t+5<NT;t+=2){
    STEP(pB0,pB1,pA0,pA1,t,true,true,true);     WAIT_BAR(2); RESC(); ROT();
    STEP(pA0,pA1,pB0,pB1,t+1,true,true,true);   WAIT_BAR(2); RESC(); ROT();
  }
  #undef CMASK
  #define CMASK(P0,P1,t) do{}while(0)
  #define ENDW(tt) do{ if((tt)+3<NT){WAIT_BAR(2);} else if((tt)+2<NT){WAIT_BAR(1);} else {WAIT_BAR(0);} }while(0)
  for(;t+1<NT;t+=2){
    STEP(pB0,pB1,pA0,pA1,t,(t+3<NT),(t+1<NT),(t+1<NT));       ENDW(t);   RESC(); ROT();
    STEP(pA0,pA1,pB0,pB1,t+1,(t+4<NT),(t+2<NT),(t+2<NT));     ENDW(t+1); RESC(); ROT();
  }
  STEP(pB0,pB1,pA0,pA1,NT-1,false,false,false); RESC();
  { float sacc=pB0[0]+pB0[1]; _Pragma("unroll") for(int r=2;r<16;++r)sacc+=pB0[r]; _Pragma("unroll") for(int r=0;r<16;++r)sacc+=pB1[r]; l_reg+=sacc;
    pw0=(u32x4){PKW(pB0,0),PKW(pB0,2),PKW(pB0,4),PKW(pB0,6)};pw1=(u32x4){PKW(pB0,8),PKW(pB0,10),PKW(pB0,12),PKW(pB0,14)};pw2=(u32x4){PKW(pB1,0),PKW(pB1,2),PKW(pB1,4),PKW(pB1,6)};pw3=(u32x4){PKW(pB1,8),PKW(pB1,10),PKW(pB1,12),PKW(pB1,14)};
    SBAR(); pv(o,vb0+sl_cur,PAF(0),PAF(1),PAF(2),PAF(3)); }
  #undef PKW
  #undef PAF
  #undef VFR
  #undef PIN
  #undef MX3
  #undef GAPA
  #undef GAPB
  #undef EX
  #undef VRD
  #undef KRD
  #undef STEP
  #undef ENDW
  {auto rr=__builtin_amdgcn_permlane32_swap(__float_as_uint(l_reg),__float_as_uint(l_reg),false,false);l_reg=__uint_as_float(rr[0])+__uint_as_float(rr[1]);}
  if(hi==0)wsf[32+r32]=l_reg;asm volatile("s_waitcnt lgkmcnt(0)":::"memory");
  float rli[16];
  #pragma unroll
  for(int r=0;r<16;++r)rli[r]=__builtin_amdgcn_rcpf(wsf[32+crow(r,hi)]);
  bf16*Ow=O+(rowbase+q0+wid*QBLK)*DM+h*D;
  { bf16*stg=(bf16*)(shm+LDS_OST)+wid*2048;
    #pragma unroll
    for(int r=0;r<16;++r){const int orow=crow(r,hi);
      #pragma unroll
      for(int d0=0;d0<2;++d0)stg[orow*64+d0*32+r32]=__float2bfloat16(o[d0][r]*rli[r]);}
    asm volatile("s_waitcnt lgkmcnt(0)":::"memory");
    #pragma unroll
    for(int i=0;i<4;++i){const int row=i*8+(lane>>3),ch=lane&7; const u32x4 v=*(const u32x4*)(stg+row*64+ch*8); ATTN_STORE16(Ow+(long)row*DM+ch*8,v);} }
  asm volatile("s_waitcnt lgkmcnt(0)\n\ts_barrier":::"memory");
  #undef DMA_K
  #undef DMA_V
  #undef CMASK
  #undef START
  #undef RESC
  #undef ROT
}
constexpr int ATTN_LDS_BYTES=LDS_BYTES;
struct AttnTensors { const bf16* Q; const bf16* K; const bf16* V; bf16* O; };
struct AttnUnit { int bh; int qb; };
struct StaticOrder {
  int vcu, G, bid;
  __device__ __forceinline__ explicit StaticOrder(int grid,int block):vcu((grid%8==0)?(block%8)*(grid/8)+block/8:block),G(grid),bid(block){}
  __device__ __forceinline__ bool next(int i,AttnUnit&u)const{
    if(G==256){ if(i>=8)return false; const int xcd=vcu>>5,c=vcu&31,kvg=xcd+8*(i>>2);
      u.bh=(kvg>>2)*16+(kvg&3)*4+(c>>3); u.qb=(c&7)*4+(i&3); return true; }
    const int id=i*G+bid; if(id>=BATCH*NHEAD*NQB)return false; u.bh=id/NQB; u.qb=id%NQB; return true; }
  __device__ __forceinline__ void a_ready(const AttnUnit&)const{}
  __device__ __forceinline__ void done(const AttnUnit&)const{}
};
template<class Sched,int THRL=8> __device__ __forceinline__ void attn_phase(char*lds,const AttnTensors&T,const Sched&S){
  AttnUnit u;
  for(int i=0;S.next(i,u);++i){ S.a_ready(u); attn_unit<THRL>(u.bh/NHEAD,u.bh%NHEAD,u.qb,T.Q,T.K,T.V,T.O,lds); S.done(u); }
}
#undef SBAR
#undef WAIT_BAR
}

constexpr size_t MiB = 1u << 20;
constexpr size_t WS_MODP = 1 * MiB;
constexpr size_t WS_MOD  = 4 * MiB;
constexpr size_t WS_A2   = 5 * MiB;
constexpr size_t WS_LP   = 7 * MiB + 512 * 1024;
constexpr size_t WS_BBAR = 10 * MiB;
constexpr size_t WS_KTAB = 11 * MiB;
constexpr size_t WS_SS   = 15 * MiB;
constexpr size_t WS_BIAS = 1 * MiB;
constexpr size_t R_H2 = 168 * MiB + 192 * MiB;
constexpr size_t WS_ROPE = 2 * MiB;
constexpr size_t WS_BAR  = 4 * MiB + 384 * 1024;
constexpr size_t WS_W    = 16 * MiB;
constexpr size_t WS_H    = 104 * MiB;
constexpr size_t WS_R    = 168 * MiB;
constexpr size_t WS_END  = 512 * MiB;
constexpr size_t WO_UP(int i) { return (size_t)i * 8650752; }
constexpr size_t WO_DN(int i) { return (size_t)i * 8650752 + 5767168; }
constexpr size_t WO_QKV(int j) { return 34603008 + (size_t)j * 2621440; }
constexpr size_t WO_WO(int j) { return 34603008 + (size_t)j * 2621440 + 1572864; }
constexpr size_t WO_HIN = 39845888, WO_HOUT = 39845888 + 3145728, WO_GLU = 44040192;
constexpr size_t R_QKV = WS_R, R_QN = WS_R + 96 * MiB, R_KN = WS_R + 160 * MiB, R_VC = WS_R + 176 * MiB;
constexpr size_t R_G = WS_R, R_HALO = WS_R + 176 * MiB;
constexpr size_t R_UPRE = WS_R, R_X1 = WS_R + 192 * MiB, R_X2 = WS_R + 256 * MiB;
constexpr size_t R_Z1S = WS_R + 192 * MiB, R_KFS = WS_R + 224 * MiB, R_Z2 = WS_H, R_Z2T = WS_R;
constexpr size_t R_BT1 = WS_R, R_CM = WS_R + 48 * MiB, R_YI = WS_R + 64 * MiB, R_S = WS_R + 128 * MiB, R_XC = WS_R + 192 * MiB;

constexpr int RING_BYTES = 131072, MISC_OFF = RING_BYTES, LDS_BYTES = 147456;

struct Args { const float* in[35]; float* out; unsigned char* ws; int ph_lo, ph_hi; unsigned char prog[96][4]; };
enum Kind { K_PRO = 0, K_MODRED, K_NORMMOD, K_GEMM_QKV, K_QKN, K_ATT, K_GEMM_WO, K_GEMM_UP, K_FFNCONV, K_GEMM_DN, K_GEMM_HIN, K_HCT, K_HFFT, K_HTR, K_GEMM_HOUT,
            K_S5PREP, K_GEMM_S1, K_S5SCAN, K_GEMM_S2, K_GEMM_GLU, K_FINAL };

struct Ctx { LAS unsigned char* lds; int tid, lane, wave, G, vcu, gw, NGW, bid; };

__device__ __forceinline__ void transpose_item(const float* W, int K, int N, bf16_t* WT, int mode, LAS float* scr, int item, int lane) {
    const int nblk = N / 32, kb = item / nblk, nb = item % nblk, k0 = 64 * kb, n0 = 32 * nb;
    float tv[32];
#pragma unroll
    for (int i = 0; i < 32; ++i) tv[i] = W[(size_t)(k0 + 2 * i + (lane >> 5)) * N + n0 + (lane & 31)];
#pragma unroll
    for (int i = 0; i < 32; ++i) scr[(2 * i + (lane >> 5)) * 33 + (lane & 31)] = tv[i];
    asm volatile("s_waitcnt lgkmcnt(0)" ::: "memory");
    int r0 = n0;
    if (mode == 1) { const int half = n0 >> 10, c = n0 & 1023; r0 = 256 * (c >> 7) + 128 * half + (c & 127); }
    if (mode == 2) { const int half = n0 / DFF, c = n0 - half * DFF; r0 = 256 * (c >> 7) + 128 * half + (c & 127); }
    const int c = lane & 7;
#pragma unroll
    for (int j = 0; j < 4; ++j) { const int n = (lane >> 3) + 8 * j; const LAS float* s = scr + (8 * c) * 33 + n;
        u32x4 o; o.x = pk2(s[0 * 33], s[1 * 33]); o.y = pk2(s[2 * 33], s[3 * 33]); o.z = pk2(s[4 * 33], s[5 * 33]); o.w = pk2(s[6 * 33], s[7 * 33]);
        *(u32x4*)(WT + (size_t)(r0 + n) * K + k0 + 8 * c) = o; }
    asm volatile("s_waitcnt lgkmcnt(0)" ::: "memory");
}

__device__ __forceinline__ void phase_prologue(const Ctx& F, const Args& a) {
    bf16_t* Wb = (bf16_t*)(a.ws + WS_W);
    LAS float* scr = (LAS float*)(F.lds + F.wave * 16384);
    for (int it = F.gw; it < 22528; it += F.NGW) {
        int r = it; const float* src; int K, N, mode = 0; size_t dsto;
        if (r < 4 * 4224) { const int i = r / 4224; r -= i * 4224;
            if (r < 2816) { src = a.in[31] + (size_t)i * 1024 * 5632; K = 1024; N = 5632; dsto = WO_UP(i); mode = 2; }
            else { r -= 2816; src = a.in[34] + (size_t)i * 2816 * 1024; K = 2816; N = 1024; dsto = WO_DN(i); } }
        else { r -= 4 * 4224;
            if (r < 2 * 1280) { const int j = r / 1280; r -= j * 1280;
                if (r < 768) { src = a.in[7] + (size_t)j * 1024 * 1536; K = 1024; N = 1536; dsto = WO_QKV(j); }
                else { r -= 768; src = a.in[8] + (size_t)j * 1024 * 1024; K = 1024; N = 1024; dsto = WO_WO(j); } }
            else { r -= 2 * 1280;
                if (r < 1536) { src = a.in[11]; K = 1024; N = 3072; dsto = WO_HIN; }
                else if (r < 2048) { r -= 1536; src = a.in[21]; K = 1024; N = 1024; dsto = WO_HOUT; }
                else { r -= 2048; src = a.in[30]; K = 1024; N = 2048; dsto = WO_GLU; mode = 1; } } }
        transpose_item(src, K, N, Wb + dsto, mode, scr, r, F.lane);
    }
    { f32x4* SS = (f32x4*)(a.ws + WS_SS); const float one = (1.0f - EPS) * (float)DM;
      for (int i = F.gw * 64 + F.lane; i < 8 * TOK / 4; i += F.NGW * 64) SS[i] = (i < TOK / 4) ? (f32x4){one, one, one, one} : (f32x4){0.f, 0.f, 0.f, 0.f}; }
    {
        const float* c = a.in[1]; const float* aw = a.in[2]; float* modp = (float*)(a.ws + WS_MODP);
        for (int it = F.gw; it < 768; it += F.NGW) {
            const int kc = it & 7, nb = (it >> 3) % 24, i = it / 192;
            f32x4 acc[4]; for (int b = 0; b < 4; ++b) acc[b] = (f32x4){0.f, 0.f, 0.f, 0.f};
            const float* wp = aw + ((size_t)i * 1024 + kc * 128) * 6144 + nb * 256 + F.lane * 4;
#pragma unroll 1
            for (int k0 = 0; k0 < 128; k0 += 16) { f32x4 wv[16];
#pragma unroll
                for (int k = 0; k < 16; ++k) wv[k] = *(const f32x4*)(wp + (size_t)(k0 + k) * 6144);
#pragma unroll
                for (int k = 0; k < 16; ++k)
#pragma unroll
                    for (int b = 0; b < 4; ++b) { const float cv = c[b * 1024 + kc * 128 + k0 + k]; const float ca = cv * sigmoidf_(cv); acc[b] = acc[b] + wv[k] * ca; } }
            { float* modo = (float*)(a.ws + WS_MOD); const f32x4 bia = (kc == 0) ? *(const f32x4*)(a.in[3] + (size_t)i * 6144 + nb * 256 + F.lane * 4) : (f32x4){0.f, 0.f, 0.f, 0.f};
#pragma unroll
              for (int b = 0; b < 4; ++b) { float* mp = modo + ((size_t)i * 4 + b) * 6144 + nb * 256 + F.lane * 4;
#pragma unroll
                  for (int e = 0; e < 4; ++e) atomicAdd(mp + e, acc[b][e] + bia[e]); } }
        }
    }
    {
        const float *w1 = a.in[14], *b1 = a.in[15], *w2 = a.in[16], *b2 = a.in[17], *fq = a.in[19]; float* A2 = (float*)(a.ws + WS_A2);
        const int j = F.lane; const float fj = fq[j], b1j = b1[j], b2j = b2[j];
        for (int it = F.gw; it < SEQ / 4; it += F.NGW) {
            const int t0 = it * 4;
            for (int tt = 0; tt < 4; ++tt) {
                const int t = t0 + tt;
                const float tl = (float)t * (1.0f / (float)(SEQ - 1));
                const float w = 6.283185307179586f * (float)t / (float)SEQ;
                float s = tl * w1[j] + b1j;
#pragma unroll
                for (int k = 0; k < 16; ++k) { const float f = 1e-4f + (float)k * ((15.0f - 1e-4f) / 15.0f); const float ang = w * f;
                    s += cosf(ang) * w1[(1 + k) * 64 + j]; s += -sinf(ang) * w1[(17 + k) * 64 + j]; }
                const float a1 = sinf(fj * s);
                float s2 = b2j;
                for (int i = 0; i < 64; ++i) s2 += bperm(a1, i) * w2[i * 64 + j];
                scr[j * 5 + tt] = sinf(fj * s2);
            }
            asm volatile("s_waitcnt lgkmcnt(0)" ::: "memory");
#pragma unroll
            for (int r = 0; r < 4; ++r) { const int idx = r * 64 + F.lane, jj = idx >> 2, tt = idx & 3; A2[(size_t)jj * (SEQ + 64) + t0 + tt] = scr[jj * 5 + tt]; }
            asm volatile("s_waitcnt lgkmcnt(0)" ::: "memory");
        }
    }
    {
        const float *Are = a.in[22], *Aim = a.in[23], *ldt = a.in[24], *Bre = a.in[25], *Bim = a.in[26];
        f32x2* LP = (f32x2*)(a.ws + WS_LP); f32x2* BB = (f32x2*)(a.ws + WS_BBAR);
        for (int it = F.gw; it < 128; it += F.NGW) {
            const int g = it >> 1, dir = it & 1, p = F.lane;
            const float lre = fminf(Are[(dir * 64 + g) * 64 + p], -1e-4f), lim = Aim[(dir * 64 + g) * 64 + p]; const float dt = expf(ldt[dir * 64 + g]);
            for (int n = 0; n <= 32; ++n) { const float mg = expf((float)n * lre * dt), an = (float)n * lim * dt; LP[((size_t)(g * 2 + dir) * 33 + n) * 64 + p] = (f32x2){mg * cosf(an), mg * sinf(an)}; }
            const float mg = expf(lre * dt), an = lim * dt; const float nr = mg * cosf(an) - 1.0f, ni = mg * sinf(an);
            const float den = lre * lre + lim * lim; const float cr = (nr * lre + ni * lim) / den, ci = (ni * lre - nr * lim) / den;
            for (int h = 0; h < 16; ++h) { const size_t bi = ((size_t)(dir * 64 + g) * 64 + p) * 16 + h; const float br = Bre[bi], bm = Bim[bi];
                BB[((size_t)(g * 2 + dir) * 64 + p) * 16 + h] = (f32x2){cr * br - ci * bm, cr * bm + ci * br}; }
        }
    }
}

__device__ __forceinline__ void phase_modred(const Ctx& F, const Args& a) {
    const float *Cre = a.in[27], *Cim = a.in[28]; const f32x2* LP = (const f32x2*)(a.ws + WS_LP); const f32x2* BB = (const f32x2*)(a.ws + WS_BBAR); float* KT = (float*)(a.ws + WS_KTAB);
    for (int it = F.gw; it < 64 * 2 * 32; it += F.NGW) {
        const int tau = it & 31, dir = (it >> 5) & 1, g = it >> 6; const int gd = g * 2 + dir;
        const int ho = F.lane >> 2, hi0 = 4 * (F.lane & 3); float acc[4] = {0.f, 0.f, 0.f, 0.f};
#pragma unroll 1
        for (int p0 = 0; p0 < 64; p0 += 8) {
            f32x2 lv[8]; float crv[8], cmv[8]; f32x4 bv[8][2];
#pragma unroll
            for (int k = 0; k < 8; ++k) { const int p = p0 + k; lv[k] = LP[((size_t)gd * 33 + tau) * 64 + p]; const size_t ci = ((size_t)(dir * 64 + g) * 16 + ho) * 64 + p; crv[k] = Cre[ci]; cmv[k] = Cim[ci];
                const f32x4* bp = (const f32x4*)(BB + ((size_t)gd * 64 + p) * 16 + hi0); bv[k][0] = bp[0]; bv[k][1] = bp[1]; }
#pragma unroll
            for (int k = 0; k < 8; ++k) { const float er = crv[k] * lv[k].x - cmv[k] * lv[k].y, ei = crv[k] * lv[k].y + cmv[k] * lv[k].x;
                acc[0] += er * bv[k][0].x - ei * bv[k][0].y; acc[1] += er * bv[k][0].z - ei * bv[k][0].w; acc[2] += er * bv[k][1].x - ei * bv[k][1].y; acc[3] += er * bv[k][1].z - ei * bv[k][1].w; }
        }
        *(f32x4*)(KT + (((size_t)gd * 32 + tau) * 16 + ho) * 16 + hi0) = (f32x4){acc[0], acc[1], acc[2], acc[3]};
    }
}

__device__ __forceinline__ void phase_normmod(const Ctx& F, const Args& a, int layer, int which) {
    const bool first = (layer == 0 && which == 0);
    const float* src = first ? a.in[0] : a.out; float* X = a.out; bf16_t* H = (bf16_t*)(a.ws + WS_H);
    const float* gn = (which ? a.in[5] : a.in[4]) + layer * 1024; const float* mod = (const float*)(a.ws + WS_MOD) + (size_t)layer * 4 * 6144 + which * 3072;
    const int rows_per = TOK / F.NGW;
    const int r0 = F.gw * rows_per, b = r0 / SEQ;
    f32x4 cs[4], sh[4];
#pragma unroll
    for (int j = 0; j < 4; ++j) { const int c = (F.lane + 64 * j) * 4; const f32x4 g = *(const f32x4*)(gn + c), sc = *(const f32x4*)(mod + (size_t)b * 6144 + 1024 + c); sh[j] = *(const f32x4*)(mod + (size_t)b * 6144 + c); cs[j] = g * (sc + 1.0f); }
#pragma unroll 1
    for (int r = r0; r < r0 + rows_per; r += 4) {
        f32x4 v[4][4];
#pragma unroll
        for (int q = 0; q < 4; ++q) { const f32x4* xr = (const f32x4*)(src + (size_t)(r + q) * DM) + F.lane;
#pragma unroll
            for (int j = 0; j < 4; ++j) v[q][j] = xr[64 * j]; }
#pragma unroll
        for (int q = 0; q < 4; ++q) { float s = 0.f;
#pragma unroll
            for (int j = 0; j < 4; ++j) s += (v[q][j].x * v[q][j].x + v[q][j].y * v[q][j].y) + (v[q][j].z * v[q][j].z + v[q][j].w * v[q][j].w);
            const float rstd = 1.0f / sqrtf(wave_sum(s, F.lane) * (1.0f / DM) + EPS);
            u32x2* o8 = (u32x2*)(H + (size_t)(r + q) * DM) + F.lane;
#pragma unroll
            for (int j = 0; j < 4; ++j) { const f32x4 y = v[q][j] * rstd * cs[j] + sh[j]; o8[64 * j] = (u32x2){pk2(y.x, y.y), pk2(y.z, y.w)}; }
            }
    }
}
__device__ __forceinline__ void phase_bias(const Ctx& F, const Args& a) {
    const bf16_t* Wb = (const bf16_t*)(a.ws + WS_W); const float* mod = (const float*)(a.ws + WS_MOD); float* bias = (float*)(a.ws + WS_BIAS);
    const int per = (pg8::NBIAS + F.NGW - 1) / F.NGW; const int r0 = F.gw * per, r1 = (r0 + per < pg8::NBIAS) ? r0 + per : pg8::NBIAS;
    {
        f32x2* rope = (f32x2*)(a.ws + WS_ROPE); const int pi = F.lane & 31; const float inv = 1.0f / powf(10000.0f, (float)(pi & 15) / 16.0f);
        for (int it = F.gw; it < SEQ / 2; it += F.NGW) { const int t = it * 2 + (F.lane >> 5); const float pos = (pi < 16) ? (float)(t >> 6) : (float)(t & 63); const float ang = pos * inv;
            rope[(size_t)t * 32 + pi] = (f32x2){cosf(ang), sinf(ang)}; }
    }
    int cur = -1; f32x4 sh[4][4];
    auto rowptr = [&](int row, int& cons, int& layer, int& which) -> const bf16_t* {
        if (row < 22528) { layer = row / 5632; which = 1; cons = layer; return Wb + WO_UP(layer) + (size_t)(row - layer * 5632) * 1024; }
        if (row < 25600) { layer = 1; which = 0; cons = 4; return Wb + WO_HIN + (size_t)(row - 22528) * 1024; }
        layer = 3; which = 0; cons = 5; return Wb + WO_QKV(1) + (size_t)(row - 25600) * 1024; };
#pragma unroll 1
    for (int rb = r0; rb < r1; rb += 4) {
        u32x4 wv[4][2];
#pragma unroll
        for (int k = 0; k < 4; ++k) { const int row = (rb + k < r1) ? rb + k : r1 - 1; int c_, l_, w_; const bf16_t* wrow = rowptr(row, c_, l_, w_); wv[k][0] = *(const u32x4*)(wrow + F.lane * 16); wv[k][1] = *(const u32x4*)(wrow + F.lane * 16 + 8); }
#pragma unroll
        for (int k = 0; k < 4; ++k) { const int row = rb + k; if (row >= r1) break;
            int cons, layer, which; (void)rowptr(row, cons, layer, which);
            if (cons != cur) { cur = cons;
#pragma unroll
                for (int b = 0; b < 4; ++b)
#pragma unroll
                    for (int q = 0; q < 4; ++q) sh[b][q] = *(const f32x4*)(mod + ((size_t)layer * 4 + b) * 6144 + which * 3072 + F.lane * 16 + 4 * q); }
            float wf[16];
#pragma unroll
            for (int e = 0; e < 4; ++e) { wf[2 * e] = bflo(wv[k][0][e]); wf[2 * e + 1] = bfhi(wv[k][0][e]); wf[8 + 2 * e] = bflo(wv[k][1][e]); wf[9 + 2 * e] = bfhi(wv[k][1][e]); }
#pragma unroll
            for (int b = 0; b < 4; ++b) { float d = 0.f;
#pragma unroll
                for (int q = 0; q < 4; ++q) d += (sh[b][q].x * wf[4 * q] + sh[b][q].y * wf[4 * q + 1]) + (sh[b][q].z * wf[4 * q + 2] + sh[b][q].w * wf[4 * q + 3]);
                d = wave_sum(d, F.lane); if (F.lane == 0) bias[(size_t)b * pg8::NBIAS + row] = d; }
        }
    }
}
__device__ __forceinline__ void phase_final(const Ctx& F, const Args& a) {
    float* X = a.out; const float* gn = a.in[6];
    f32x4 g[4];
#pragma unroll
    for (int j = 0; j < 4; ++j) g[j] = *(const f32x4*)(gn + (F.lane + 64 * j) * 4);
    const int rows_per = TOK / F.NGW; const int r0 = F.gw * rows_per;
#pragma unroll 1
    for (int r = r0; r < r0 + rows_per; r += 4) {
        f32x4 v[4][4];
#pragma unroll
        for (int q = 0; q < 4; ++q) { const f32x4* xr = (const f32x4*)(X + (size_t)(r + q) * DM) + F.lane;
#pragma unroll
            for (int j = 0; j < 4; ++j) v[q][j] = xr[64 * j]; }
#pragma unroll
        for (int q = 0; q < 4; ++q) { float s = 0.f;
#pragma unroll
            for (int j = 0; j < 4; ++j) s += (v[q][j].x * v[q][j].x + v[q][j].y * v[q][j].y) + (v[q][j].z * v[q][j].z + v[q][j].w * v[q][j].w);
            const float rstd = 1.0f / sqrtf(wave_sum(s, F.lane) * (1.0f / DM) + EPS);
            f32x4* xo = (f32x4*)(X + (size_t)(r + q) * DM) + F.lane;
#pragma unroll
            for (int j = 0; j < 4; ++j) xo[64 * j] = v[q][j] * rstd * g[j]; }
    }
}

__device__ __forceinline__ void phase_qknorm(const Ctx& F, const Args& a, int j) {
    const bf16_t* QKV = (const bf16_t*)(a.ws + R_QKV); bf16_t* Qn = (bf16_t*)(a.ws + R_QN); bf16_t* Kn = (bf16_t*)(a.ws + R_KN); bf16_t* Vc = (bf16_t*)(a.ws + R_VC);
    const float* qg = a.in[9] + j * 64; const float* kg = a.in[10] + j * 64;
    const int sub = F.lane & 15, e0 = sub * 4, hsel = F.lane >> 4;
    const f32x4 gq = *(const f32x4*)(qg + e0), gk = *(const f32x4*)(kg + e0);
    const int i0 = 2 * sub, i1 = 2 * sub + 1;
    const float inv0 = 1.0f / powf(10000.0f, (float)(i0 & 15) / 16.0f), inv1 = 1.0f / powf(10000.0f, (float)(i1 & 15) / 16.0f);
    const float C2 = 0.125f * 1.4426950408889634f;
    const int rows_per = TOK / F.NGW; const int rbeg = F.gw * rows_per;
#pragma unroll 1
    for (int rb = rbeg; rb < rbeg + rows_per; rb += 4) {
        u32x2 wq[4][5], wv[4];
#pragma unroll
        for (int q = 0; q < 4; ++q) { const bf16_t* src = QKV + (size_t)(rb + q) * NQKV;
#pragma unroll
            for (int it = 0; it < 5; ++it) wq[q][it] = *(const u32x2*)(src + (it * 4 + hsel) * 64 + e0);
            wv[q] = *(const u32x2*)(src + 1280 + F.lane * 4); }
#pragma unroll
        for (int q = 0; q < 4; ++q) {
            const int row = rb + q; const int t = row & (SEQ - 1); const float pos = (i0 < 16) ? (float)(t >> 6) : (float)(t & 63);
            const float a0 = pos * inv0, a1 = pos * inv1; const float c0 = cosf(a0), s0 = sinf(a0), c1 = cosf(a1), s1 = sinf(a1);
#pragma unroll
            for (int it = 0; it < 5; ++it) {
                const int head = it * 4 + hsel; const u32x2 w = wq[q][it];
                float v0 = bflo(w.x), v1 = bfhi(w.x), v2 = bflo(w.y), v3 = bfhi(w.y);
                float ss = v0 * v0 + v1 * v1 + v2 * v2 + v3 * v3;
                ss += bperm(ss, F.lane ^ 1); ss += bperm(ss, F.lane ^ 2); ss += bperm(ss, F.lane ^ 4); ss += bperm(ss, F.lane ^ 8);
                const float rstd = 1.0f / sqrtf(ss * (1.0f / 64.0f) + EPS);
                const f32x4 gg = (it < 4) ? gq : gk;
                v0 *= rstd * gg.x; v1 *= rstd * gg.y; v2 *= rstd * gg.z; v3 *= rstd * gg.w;
                float o0 = v0 * c0 - v1 * s0, o1 = v0 * s0 + v1 * c0, o2 = v2 * c1 - v3 * s1, o3 = v2 * s1 + v3 * c1;
                if (it < 4) { o0 *= C2; o1 *= C2; o2 *= C2; o3 *= C2; *(u32x2*)(Qn + (size_t)row * 1024 + head * 64 + e0) = (u32x2){pk2(o0, o1), pk2(o2, o3)}; }
                else *(u32x2*)(Kn + (size_t)row * 256 + (head - 16) * 64 + e0) = (u32x2){pk2(o0, o1), pk2(o2, o3)};
            }
            *(u32x2*)(Vc + (size_t)row * 256 + F.lane * 4) = wv[q];
        }
    }
}

__device__ __forceinline__ void phase_ffnfix(const Ctx& F, const Args& a, int layer) {
    bf16_t* Gb = (bf16_t*)(a.ws + R_G); const float* halo = (const float*)(a.ws + R_HALO);
    const float* cw = a.in[32] + (size_t)layer * 3 * DFF; const float* cb = a.in[33] + (size_t)layer * DFF;
    for (int it = F.gw; it < 128 * 2 * 11; it += F.NGW) {
        const int seg = it % 11, lastrow = (it / 11) & 1, pm = it / 22; const int c = seg * 256 + F.lane * 4;
        const float* hp = halo + (size_t)pm * 6 * DFF + c;
        f32x4 pv, cv, nv, vv;
        if (!lastrow) { pv = (pm % 32 == 0) ? (f32x4){0.f, 0.f, 0.f, 0.f} : *(const f32x4*)(hp - 6 * DFF + 3 * DFF); cv = *(const f32x4*)hp; nv = *(const f32x4*)(hp + DFF); vv = *(const f32x4*)(hp + 4 * DFF); }
        else { pv = *(const f32x4*)(hp + 2 * DFF); cv = *(const f32x4*)(hp + 3 * DFF); nv = (pm % 32 == 31) ? (f32x4){0.f, 0.f, 0.f, 0.f} : *(const f32x4*)(hp + 6 * DFF); vv = *(const f32x4*)(hp + 5 * DFF); }
        const f32x4 w0 = *(const f32x4*)(cw + c), w1 = *(const f32x4*)(cw + DFF + c), w2 = *(const f32x4*)(cw + 2 * DFF + c), bb = *(const f32x4*)(cb + c);
        const f32x4 gt = pv * w0 + cv * w1 + nv * w2 + bb; float o[4];
#pragma unroll
        for (int e = 0; e < 4; ++e) o[e] = gt[e] * sigmoidf_(gt[e]) * vv[e];
        *(u32x2*)(Gb + (size_t)(pm * 256 + (lastrow ? 255 : 0)) * DFF + c) = (u32x2){pk2(o[0], o[1]), pk2(o[2], o[3])};
    }
}

__device__ __forceinline__ void phase_hyconvT(const Ctx& F, const Args& a) {
    const bf16_t* Up = (const bf16_t*)(a.ws + R_UPRE); const float* cw = a.in[12]; const float* cb = a.in[13];
    for (int it = F.gw; it < 4 * 3 * 16 * 128; it += F.NGW) {
        const int tb = it & 127, cbk = (it >> 7) & 15, part = (it >> 11) % 3, b = it / (3 * 2048);
        const int col = part * 1024 + cbk * 64 + F.lane; const int t0 = tb * 64;
        bf16_t* dst = (bf16_t*)(a.ws + (part == 0 ? WS_H : part == 1 ? R_X1 : R_X2)) + ((size_t)(b * 1024 + cbk * 64 + F.lane)) * SEQ + t0;
        const float w0 = cw[col], w1 = cw[3072 + col], w2 = cw[6144 + col], bb = cb[col];
        const bf16_t* sp = Up + ((size_t)b * SEQ + t0) * 3072 + col;
        unsigned short pv[66];
#pragma unroll
        for (int i = 0; i < 66; ++i) { const int t = t0 - 1 + i; pv[i] = (t >= 0 && t < SEQ) ? sp[(ptrdiff_t)(i - 1) * 3072] : (unsigned short)0; }
#pragma unroll
        for (int q = 0; q < 8; ++q) {
            float o[8];
#pragma unroll
            for (int e = 0; e < 8; ++e) { const int tt = q * 8 + e; o[e] = bf2f(pv[tt]) * w0 + bf2f(pv[tt + 1]) * w1 + bf2f(pv[tt + 2]) * w2 + bb; }
            *(u32x4*)(dst + q * 8) = (u32x4){pk2(o[0], o[1]), pk2(o[2], o[3]), pk2(o[4], o[5]), pk2(o[6], o[7])};
        }
    }
}
__device__ __forceinline__ void phase_hytr(const Ctx& F, const Args& a) {
    const bf16_t* Z2 = (const bf16_t*)(a.ws + R_Z2); bf16_t* H = (bf16_t*)(a.ws + R_Z2T);
    for (int it = F.gw; it < 4 * 16 * 128; it += F.NGW) {
        const int tb = it & 127, cbk = (it >> 7) & 15, b = it >> 11; const int t0 = tb * 64, c = cbk * 64 + F.lane;
        const bf16_t* sp = Z2 + ((size_t)(b * 1024 + c)) * SEQ + t0; bf16_t* dp = H + ((size_t)b * SEQ + t0) * 1024 + c;
        u32x4 wq[8];
#pragma unroll
        for (int q = 0; q < 8; ++q) wq[q] = *(const u32x4*)(sp + q * 8);
#pragma unroll
        for (int q = 0; q < 8; ++q) { const u32x4 w = wq[q]; bf16_t* d = dp + (size_t)(q * 8) * 1024;
            d[0] = (bf16_t)(w.x & 0xffff); d[1024] = (bf16_t)(w.x >> 16); d[2048] = (bf16_t)(w.y & 0xffff); d[3072] = (bf16_t)(w.y >> 16);
            d[4096] = (bf16_t)(w.z & 0xffff); d[5120] = (bf16_t)(w.z >> 16); d[6144] = (bf16_t)(w.w & 0xffff); d[7168] = (bf16_t)(w.w >> 16); }
    }
}

constexpr int FN = 16384;
constexpr int A2S = SEQ + 64;
__device__ __forceinline__ int fswz(int i) { return i ^ ((i >> 5) & 31); }
__host__ __device__ constexpr float cos16(int k) { k &= 15; return k == 0 ? 1.f : k == 1 ? 0.92387953251f : k == 2 ? 0.70710678119f : k == 3 ? 0.38268343237f : k == 4 ? 0.f : k == 5 ? -0.38268343237f : k == 6 ? -0.70710678119f : k == 7 ? -0.92387953251f
    : k == 8 ? -1.f : k == 9 ? -0.92387953251f : k == 10 ? -0.70710678119f : k == 11 ? -0.38268343237f : k == 12 ? 0.f : k == 13 ? 0.38268343237f : k == 14 ? 0.70710678119f : 0.92387953251f; }
__host__ __device__ constexpr float sin16(int k) { return cos16(k + 12); }
template <int R, int LSTR, bool INV, int NG>
__device__ __forceinline__ void fft_stages(f32x2 (&v)[NG][1 << R], const int (&jv)[NG]) {
    constexpr int NE = 1 << R;
#pragma unroll
    for (int rr = 0; rr < R; ++rr) {
        const int r = INV ? (R - 1 - rr) : rr; const int dq = 1 << (R - 1 - r);
#pragma unroll
        for (int gI = 0; gI < NG; ++gI) {
            const float fr0 = (float)jv[gI] * (1.0f / (float)(1 << (LSTR + R - r)));
            const float cs = __builtin_amdgcn_cosf(fr0), sn = __builtin_amdgcn_sinf(fr0);
            const f32x2 w0 = {cs, INV ? sn : -sn};
#pragma unroll
            for (int q = 0; q < NE; ++q) if (!(q & dq)) {
                const int m = q & (dq - 1); const int k16 = m << (4 - (R - r));
                const float cr = cos16(k16), ci = INV ? sin16(k16) : -sin16(k16);
                f32x2 tw; if (m == 0) tw = w0; else tw = w0 * cr + (f32x2){-w0.y, w0.x} * ci;
                const f32x2 twp = {-tw.y, tw.x};
                const f32x2 x = v[gI][q], y = v[gI][q + dq];
                if (!INV) { const f32x2 d = x - y; v[gI][q] = x + y; v[gI][q + dq] = twp * d.y + tw * d.x; }
                else { const f32x2 yt = twp * y.y + tw * y.x; v[gI][q] = x + yt; v[gI][q + dq] = x - yt; }
            }
        }
    }
}
template <int R, int LSTR, bool INV>
__device__ __forceinline__ void fft_pass(LAS f32x2* cb, int tid) {
    constexpr int NE = 1 << R, STR = 1 << LSTR, NG = (R == 4) ? 2 : 1;
#pragma unroll 1
    for (int gi = tid; gi < (FN >> R); gi += 512 * NG) {
        int g2 = gi; asm volatile("" : "+v"(g2));
        int jv[NG], base[NG];
#pragma unroll
        for (int gI = 0; gI < NG; ++gI) { const int gg = g2 + 512 * gI; jv[gI] = gg & (STR - 1); base[gI] = ((gg >> LSTR) << (LSTR + R)) + jv[gI]; }
        f32x2 v[NG][NE];
#pragma unroll
        for (int gI = 0; gI < NG; ++gI)
#pragma unroll
            for (int q = 0; q < NE; ++q) v[gI][q] = cb[fswz(base[gI] + (q << LSTR))];
        fft_stages<R, LSTR, INV, NG>(v, jv);
#pragma unroll
        for (int gI = 0; gI < NG; ++gI)
#pragma unroll
            for (int q = 0; q < NE; ++q) cb[fswz(base[gI] + (q << LSTR))] = v[gI][q];
    }
    __syncthreads();
}
__device__ __forceinline__ void fft_fwd(LAS f32x2* cb, int tid) { fft_pass<4, 10, false>(cb, tid); fft_pass<4, 6, false>(cb, tid); fft_pass<4, 2, false>(cb, tid); fft_pass<2, 0, false>(cb, tid); }
__device__ __forceinline__ void fft_inv(LAS f32x2* cb, int tid) { fft_pass<2, 0, true>(cb, tid); fft_pass<4, 2, true>(cb, tid); fft_pass<4, 6, true>(cb, tid); fft_pass<4, 10, true>(cb, tid); }

__device__ __forceinline__ void fft_mid(LAS f32x2* cb, const f32x2* __restrict__ KFo, int tid) {
    f32x4 kk[16];
    { int tq = tid; asm volatile("" : "+v"(tq)); tid = tq; }
#pragma unroll
    for (int i = 0; i < 8; ++i) { const f32x2* kp = KFo + (size_t)(tid + 512 * i) * 4; kk[2 * i] = *(const f32x4*)kp; kk[2 * i + 1] = *(const f32x4*)(kp + 2); }
#pragma unroll
    for (int i = 0; i < 8; ++i) {
        const int base = (tid + 512 * i) << 2;
        f32x2 v[4]; f32x2 k[4];
#pragma unroll
        for (int q = 0; q < 4; ++q) v[q] = cb[fswz(base + q)];
        k[0] = (f32x2){kk[2 * i].x, kk[2 * i].y}; k[1] = (f32x2){kk[2 * i].z, kk[2 * i].w}; k[2] = (f32x2){kk[2 * i + 1].x, kk[2 * i + 1].y}; k[3] = (f32x2){kk[2 * i + 1].z, kk[2 * i + 1].w};
        { const f32x2 a = v[0] + v[2], b = v[0] - v[2], c = v[1] + v[3], d = v[1] - v[3]; const f32x2 dm = {d.y, -d.x};
          v[0] = a + c; v[1] = a - c; v[2] = b + dm; v[3] = b - dm; }
#pragma unroll
        for (int q = 0; q < 4; ++q) { const f32x2 z = v[q]; v[q] = k[q] * z.x + (f32x2){-k[q].y, k[q].x} * z.y; }
        { const f32x2 a = v[0] + v[1], b = v[0] - v[1], c = v[2] + v[3], d = v[2] - v[3]; const f32x2 dp = {-d.y, d.x};
          v[0] = a + c; v[2] = a - c; v[1] = b + dp; v[3] = b - dp; }
#pragma unroll
        for (int q = 0; q < 4; ++q) cb[fswz(base + q)] = v[q];
    }
    __syncthreads();
}
__device__ __forceinline__ void fft_fwd3(LAS f32x2* cb, int tid) { fft_pass<4, 10, false>(cb, tid); fft_pass<4, 6, false>(cb, tid); fft_pass<4, 2, false>(cb, tid); }
__device__ __forceinline__ void fft_inv3(LAS f32x2* cb, int tid) { fft_pass<4, 2, true>(cb, tid); fft_pass<4, 6, true>(cb, tid); fft_pass<4, 10, true>(cb, tid); }
__device__ __forceinline__ float block_sum(float v, LAS float* red, int tid) {
    v = wave_sum(v, tid & 63); __syncthreads(); if ((tid & 63) == 0) red[tid >> 6] = v; __syncthreads();
    float s = 0.f;
#pragma unroll
    for (int w = 0; w < 8; ++w) s += red[w];
    return s;
}
__device__ __forceinline__ void hy_conv16(const bf16_t* rowp, int t0, float w0, float w1, float w2, float bb, float (&out)[16]) {
    const u32x4 a0 = *(const u32x4*)(rowp + t0), a1 = *(const u32x4*)(rowp + t0 + 8);
    const float lft = (t0 > 0) ? bf2f(rowp[t0 - 1]) : 0.f, rgt = (t0 + 16 < SEQ) ? bf2f(rowp[t0 + 16]) : 0.f;
    float p[18]; p[0] = lft; p[17] = rgt;
#pragma unroll
    for (int e = 0; e < 4; ++e) { p[1 + 2 * e] = bflo(a0[e]); p[2 + 2 * e] = bfhi(a0[e]); p[9 + 2 * e] = bflo(a1[e]); p[10 + 2 * e] = bfhi(a1[e]); }
#pragma unroll
    for (int e = 0; e < 16; ++e) out[e] = w0 * p[e] + w1 * p[e + 1] + w2 * p[e + 2] + bb;
}
__device__ __forceinline__ void phase_hyfft(const Ctx& F, const Args& a) {
    LAS f32x2* cb = (LAS f32x2*)F.lds; LAS float* red = (LAS float*)(F.lds + MISC_OFF); LAS f32x4* w3l = (LAS f32x4*)(F.lds + MISC_OFF + 256);
    const float* A2 = (const float*)(a.ws + WS_A2); const float* w3 = a.in[18]; const float* skip = a.in[20];
    const bf16_t* UT = (const bf16_t*)(a.ws + R_UPRE); const float* cwp = a.in[12]; const float* cbp = a.in[13];
    float* Z1 = (float*)(a.ws + R_Z1S) + (size_t)F.bid * 4 * SEQ; f32x2* KF = (f32x2*)(a.ws + R_KFS) + (size_t)F.bid * 2 * FN; bf16_t* Z2 = (bf16_t*)(a.ws + R_Z2);
    const int tid = F.tid;
    for (int d = F.bid; d < DM; d += F.G) {
        __syncthreads();
        if (tid < 64) w3l[tid] = (f32x4){w3[tid * 4096 + d], w3[tid * 4096 + 1024 + d], w3[tid * 4096 + 2048 + d], w3[tid * 4096 + 3072 + d]};
        __syncthreads();
        const float dlo = -3.0701134573253946f, dhi = -15.350567286626973f; const float delta = fabsf(dlo + (float)d * ((dhi - dlo) / 1023.0f));
        float n0 = 0.f, n1 = 0.f;
        {
            f32x4 acc[16];
#pragma unroll
            for (int i = 0; i < 16; ++i) acc[i] = (f32x4){0.f, 0.f, 0.f, 0.f};
            int tq = tid; asm volatile("" : "+v"(tq));
            const float* ap = A2 + 4 * tq;
            f32x4 bA[8], bB[8];
#define HY_LD(buf, c) do { _Pragma("unroll") for (int jl = 0; jl < 2; ++jl) _Pragma("unroll") for (int i = 0; i < 4; ++i) buf[jl * 4 + i] = *(const f32x4*)(ap + (size_t)((c) * 2 + jl) * A2S + 2048 * i); } while (0)
#define HY_CP(buf, c) do { _Pragma("unroll") for (int jl = 0; jl < 2; ++jl) { const f32x4 w = w3l[(c) * 2 + jl]; _Pragma("unroll") for (int i = 0; i < 4; ++i) { const f32x4 av = buf[jl * 4 + i]; \
                acc[i * 4 + 0] = acc[i * 4 + 0] + w * av.x; acc[i * 4 + 1] = acc[i * 4 + 1] + w * av.y; acc[i * 4 + 2] = acc[i * 4 + 2] + w * av.z; acc[i * 4 + 3] = acc[i * 4 + 3] + w * av.w; } } } while (0)
            f32x4 bC[8];
            HY_LD(bA, 0); HY_LD(bB, 1);
#pragma unroll 1
            for (int c = 0; c < 30; c += 3) { HY_LD(bC, c + 2); HY_CP(bA, c); HY_LD(bA, c + 3); HY_CP(bB, c + 1); HY_LD(bB, c + 4); HY_CP(bC, c + 2); }
            HY_CP(bA, 30); HY_CP(bB, 31);
#undef HY_LD
#undef HY_CP
#pragma unroll
            for (int i = 0; i < 4; ++i)
#pragma unroll
                for (int e = 0; e < 4; ++e) { const int t = 4 * tq + 2048 * i + e;
                    const float dec = expf(-((float)t * (1.0f / (float)(SEQ - 1))) * delta); const f32x4 sv = acc[i * 4 + e] * dec;
                    cb[fswz(t)] = (f32x2){sv.x, sv.z}; n0 += fabsf(sv.x); n1 += fabsf(sv.z);
                    if (t > 0) { cb[fswz(2 * SEQ - t)] = (f32x2){sv.y, sv.w}; n0 += fabsf(sv.y); n1 += fabsf(sv.w); } else { float z = 0.f; asm volatile("" : "+v"(z)); cb[fswz(SEQ)] = (f32x2){z, z}; } }
        }
        n0 = block_sum(n0, red, tid); n1 = block_sum(n1, red, tid);
        __syncthreads();
        fft_fwd(cb, tid);
        { const float s0 = 0.5f / (n0 * (float)FN), s1 = 0.5f / (n1 * (float)FN);
#pragma unroll 2
          for (int p0_ = tid; p0_ < FN; p0_ += 512) { int p = p0_; asm volatile("" : "+v"(p)); const int f = (int)(__brev((unsigned)p) >> 18); const int p2 = (int)(__brev((unsigned)((FN - f) & (FN - 1))) >> 18);
              const f32x2 z = cb[fswz(p)], zc = cb[fswz(p2)];
              KF[p] = (f32x2){(z.x + zc.x) * s0, (z.y - zc.y) * s0};
              KF[FN + p] = (f32x2){(z.y + zc.y) * s1, -(z.x - zc.x) * s1}; } }
        __syncthreads();
        const float sk0 = skip[d], sk1 = skip[1024 + d];
        const float cv0 = cwp[d], cv1 = cwp[3072 + d], cv2 = cwp[6144 + d], cvb = cbp[d];
        const float c10 = cwp[1024 + d], c11 = cwp[3072 + 1024 + d], c12 = cwp[6144 + 1024 + d], c1b = cbp[1024 + d];
        const float c20 = cwp[2048 + d], c21 = cwp[3072 + 2048 + d], c22 = cwp[6144 + 2048 + d], c2b = cbp[2048 + d];
        const bf16_t* Vr = UT + (size_t)d * TOK; const bf16_t* X1r = UT + (size_t)(1024 + d) * TOK; const bf16_t* X2r = UT + (size_t)(2048 + d) * TOK;
#pragma unroll 1
        for (int o = 0; o < 2; ++o) {
#pragma unroll 1
            for (int pr = 0; pr < 2; ++pr) {
                const int b0 = 2 * pr, b1 = 2 * pr + 1;
                {   int tq = tid; asm volatile("" : "+v"(tq)); const int t0 = tq * 16; float zr[16], zi[16];
                    if (o == 0) { hy_conv16(Vr + (size_t)b0 * SEQ, t0, cv0, cv1, cv2, cvb, zr); hy_conv16(Vr + (size_t)b1 * SEQ, t0, cv0, cv1, cv2, cvb, zi); }
                    else { const f32x4* p0 = (const f32x4*)(Z1 + b0 * SEQ + t0); const f32x4* p1 = (const f32x4*)(Z1 + b1 * SEQ + t0);
#pragma unroll
                        for (int q = 0; q < 4; ++q) { const f32x4 a = p0[q], c = p1[q];
#pragma unroll
                            for (int e = 0; e < 4; ++e) { zr[4 * q + e] = a[e]; zi[4 * q + e] = c[e]; } } }
                    float z = 0.f; asm volatile("" : "+v"(z));
#pragma unroll
                    for (int e = 0; e < 16; ++e) { cb[fswz(t0 + e)] = (f32x2){zr[e], zi[e]}; cb[fswz(SEQ + t0 + e)] = (f32x2){z, z}; } }
                __syncthreads();
                fft_fwd3(cb, tid);
                fft_mid(cb, KF + o * FN, tid);
                fft_inv3(cb, tid);
                {   int tq = tid; asm volatile("" : "+v"(tq)); const int t0 = tq * 16; const size_t i0 = ((size_t)(b0 * 1024 + d)) * SEQ + t0, i1 = ((size_t)(b1 * 1024 + d)) * SEQ + t0;
                    float y0[16], y1[16];
                    if (o == 0) {
                        float xa[16], xb[16], va[16], vb[16];
                        hy_conv16(X1r + (size_t)b0 * SEQ, t0, c10, c11, c12, c1b, xa); hy_conv16(X1r + (size_t)b1 * SEQ, t0, c10, c11, c12, c1b, xb);
                        hy_conv16(Vr + (size_t)b0 * SEQ, t0, cv0, cv1, cv2, cvb, va); hy_conv16(Vr + (size_t)b1 * SEQ, t0, cv0, cv1, cv2, cvb, vb);
#pragma unroll
                        for (int e = 0; e < 16; ++e) { const f32x2 y = cb[fswz(t0 + e)]; y0[e] = xa[e] * (y.x + sk0 * va[e]); y1[e] = xb[e] * (y.y + sk0 * vb[e]); }
                        f32x4* q0 = (f32x4*)(Z1 + b0 * SEQ + t0); f32x4* q1 = (f32x4*)(Z1 + b1 * SEQ + t0);
#pragma unroll
                        for (int q = 0; q < 4; ++q) { q0[q] = (f32x4){y0[4 * q], y0[4 * q + 1], y0[4 * q + 2], y0[4 * q + 3]}; q1[q] = (f32x4){y1[4 * q], y1[4 * q + 1], y1[4 * q + 2], y1[4 * q + 3]}; }
                    } else {
                        float xa[16], xb[16];
                        hy_conv16(X2r + (size_t)b0 * SEQ, t0, c20, c21, c22, c2b, xa); hy_conv16(X2r + (size_t)b1 * SEQ, t0, c20, c21, c22, c2b, xb);
                        const f32x4* z0 = (const f32x4*)(Z1 + b0 * SEQ + t0); const f32x4* z1p = (const f32x4*)(Z1 + b1 * SEQ + t0);
                        float za[16], zb[16];
#pragma unroll
                        for (int q = 0; q < 4; ++q) { const f32x4 a = z0[q], c = z1p[q];
#pragma unroll
                            for (int e = 0; e < 4; ++e) { za[4 * q + e] = a[e]; zb[4 * q + e] = c[e]; } }
#pragma unroll
                        for (int e = 0; e < 16; ++e) { const f32x2 y = cb[fswz(t0 + e)]; y0[e] = xa[e] * (y.x + sk1 * za[e]); y1[e] = xb[e] * (y.y + sk1 * zb[e]); }
                        u32x4 oa0, oa1, ob0, ob1;
#pragma unroll
                        for (int e = 0; e < 4; ++e) { oa0[e] = pk2(y0[2 * e], y0[2 * e + 1]); oa1[e] = pk2(y0[8 + 2 * e], y0[9 + 2 * e]); ob0[e] = pk2(y1[2 * e], y1[2 * e + 1]); ob1[e] = pk2(y1[8 + 2 * e], y1[9 + 2 * e]); }
                        *(u32x4*)(Z2 + i0) = oa0; *(u32x4*)(Z2 + i0 + 8) = oa1; *(u32x4*)(Z2 + i1) = ob0; *(u32x4*)(Z2 + i1 + 8) = ob1;
                    }
                }
                __syncthreads();
            }
        }
    }
}

__device__ __forceinline__ void phase_s5prep(const Ctx& F, const Args& a) {
    const float* KT = (const float*)(a.ws + WS_KTAB); const f32x2* LP = (const f32x2*)(a.ws + WS_LP); const f32x2* BB = (const f32x2*)(a.ws + WS_BBAR);
    const float *Cre = a.in[27], *Cim = a.in[28], *Dsk = a.in[29];
    bf16_t* Bt = (bf16_t*)(a.ws + R_BT1); bf16_t* Cm = (bf16_t*)(a.ws + R_CM);
    for (int it = F.gw; it < 64 * 512; it += F.NGW) {
        const int g = it >> 9, n = it & 511, to = n >> 4, ho = n & 15; const int k0 = F.lane * 8, ti = k0 >> 4, hi0 = k0 & 15;
        float o[8];
#pragma unroll
        for (int e = 0; e < 8; ++e) { float v = 0.f;
            if (to >= ti) v += KT[(((size_t)(g * 2 + 0) * 32 + (to - ti)) * 16 + ho) * 16 + hi0 + e];
            if (ti >= to) v += KT[(((size_t)(g * 2 + 1) * 32 + (ti - to)) * 16 + ho) * 16 + hi0 + e];
            if (ti == to && hi0 + e == ho) v += Dsk[g * 16 + ho];
            o[e] = v; }
        *(u32x4*)(Bt + ((size_t)g * 768 + n) * 512 + k0) = (u32x4){pk2(o[0], o[1]), pk2(o[2], o[3]), pk2(o[4], o[5]), pk2(o[6], o[7])};
    }
    for (int it = F.gw; it < 64 * 256; it += F.NGW) {
        const int g = it >> 8, np = it & 255, dir = np >> 7, im = (np >> 6) & 1, p = np & 63; const int k0 = F.lane * 8, tl = k0 >> 4, hi0 = k0 & 15;
        const int pw = dir ? tl : 31 - tl; const f32x2 l = LP[((size_t)(g * 2 + dir) * 33 + pw) * 64 + p];
        float o[8];
#pragma unroll
        for (int e = 0; e < 8; ++e) { const f32x2 b = BB[((size_t)(g * 2 + dir) * 64 + p) * 16 + hi0 + e]; o[e] = im ? (l.x * b.y + l.y * b.x) : (l.x * b.x - l.y * b.y); }
        *(u32x4*)(Bt + ((size_t)g * 768 + 512 + np) * 512 + k0) = (u32x4){pk2(o[0], o[1]), pk2(o[2], o[3]), pk2(o[4], o[5]), pk2(o[6], o[7])};
    }
    for (int it = F.gw; it < 64 * 512; it += F.NGW) {
        const int g = it >> 9, n = it & 511, tl = n >> 4, ho = n & 15;
#pragma unroll
        for (int q = 0; q < 4; ++q) { const int kp = q * 64 + F.lane, dir = kp >> 7, im = (kp >> 6) & 1, p = kp & 63; const int pw = dir ? 32 - tl : tl + 1;
            const f32x2 l = LP[((size_t)(g * 2 + dir) * 33 + pw) * 64 + p]; const size_t ci = ((size_t)(dir * 64 + g) * 16 + ho) * 64 + p; const float cr = Cre[ci], cm = Cim[ci];
            const float v = im ? -(cr * l.y + cm * l.x) : (cr * l.x - cm * l.y);
            Cm[((size_t)g * 512 + n) * 256 + kp] = (bf16_t)f2bf(v); }
    }
}
__device__ __forceinline__ void phase_s5scan(const Ctx& F, const Args& a) {
    const float* S = (const float*)(a.ws + R_S); bf16_t* Xc = (bf16_t*)(a.ws + R_XC); const f32x2* LP = (const f32x2*)(a.ws + WS_LP);
    for (int it = F.gw; it < 64 * 2 * 4; it += F.NGW) {
        const int b = it & 3, dir = (it >> 2) & 1, g = it >> 3, p = F.lane;
        const f32x2 l = LP[((size_t)(g * 2 + dir) * 33 + 32) * 64 + p];
        float xr = 0.f, xi = 0.f;
        const size_t base = ((size_t)g * 1024 + b * 256) * 256 + dir * 128 + p;
#pragma unroll 1
        for (int c0 = 0; c0 < 256; c0 += 16) {
            float sr[16], si[16];
#pragma unroll
            for (int k = 0; k < 16; ++k) { const int c = dir ? 255 - (c0 + k) : (c0 + k); const size_t o = base + (size_t)c * 256; sr[k] = S[o]; si[k] = S[o + 64]; }
#pragma unroll
            for (int k = 0; k < 16; ++k) { const int c = dir ? 255 - (c0 + k) : (c0 + k); const size_t o = base + (size_t)c * 256;
                Xc[o] = (bf16_t)f2bf(xr); Xc[o + 64] = (bf16_t)f2bf(xi);
                const float nr = l.x * xr - l.y * xi + sr[k], ni = l.x * xi + l.y * xr + si[k]; xr = nr; xi = ni; }
        }
    }
}

#define GAS __attribute__((address_space(1)))
typedef GAS unsigned gu32;
#define XB_TMO      128
#define XB_XCNT(j)  (256  + 64 * (j))
#define XB_XSUB(j)  (1280 + 64 * (j))
#define XB_XGEN(j)  (2304 + 64 * (j))
#define XB_TOP      3328
#define XB_TOPGEN   3392
#define XCD_BAR_WORDS 3456
#define XB_SPIN_CAP (1u << 18)

__device__ __forceinline__ unsigned xb_ld(unsigned* p)              { return __hip_atomic_load(p, __ATOMIC_RELAXED, __HIP_MEMORY_SCOPE_AGENT); }
__device__ __forceinline__ unsigned xb_add(unsigned* p, unsigned v) { return __hip_atomic_fetch_add(p, v, __ATOMIC_RELAXED, __HIP_MEMORY_SCOPE_AGENT); }
__device__ __forceinline__ unsigned xb_xcc_id() { return (unsigned)__builtin_amdgcn_s_getreg((3 << 11) | 20) & 0xFu; }
#define XB_SPIN(cond, bar) do { unsigned _sp = 0; while (cond) { __builtin_amdgcn_s_sleep(1); \
    if ((++_sp & 255u) == 0u) { if (xb_ld(&(bar)[XB_TMO])) break; if (_sp > XB_SPIN_CAP) { atomicAdd(&(bar)[XB_TMO], 1u); break; } } } } while (0)

struct XcdBarrier {
    unsigned* bar; unsigned x;
    volatile LAS unsigned* st;
};

__device__ __forceinline__ XcdBarrier xcd_barrier_post(unsigned* bar, volatile LAS unsigned* st) {
    XcdBarrier b; b.bar = bar; b.x = xb_xcc_id(); b.st = st;
    if (threadIdx.x == 0) (void)xb_add(&bar[XB_XCNT(b.x)], 1u);
    return b;
}
__device__ __forceinline__ void xcd_barrier_complete(unsigned* bar, unsigned x, unsigned& nloc, unsigned& nx) {
    const unsigned G = gridDim.x * gridDim.y * gridDim.z;
    unsigned sum, cnt, mine, sp = 0u;
    for (;;) {
        sum = 0u; cnt = 0u; mine = 0u;
#pragma unroll
        for (unsigned j = 0; j < 16; ++j) { const unsigned c = xb_ld(&bar[XB_XCNT(j)]); sum += c; cnt += (c > 0u) ? 1u : 0u; mine = (j == x) ? c : mine; }
        if (sum == G) break;
        __builtin_amdgcn_s_sleep(1);
        if ((++sp & 255u) == 0u) { if (xb_ld(&bar[XB_TMO])) break; if (sp > XB_SPIN_CAP) { atomicAdd(&bar[XB_TMO], 1u); break; } }
    }
    nloc = mine > 0u ? mine : 1u; nx = cnt > 0u ? cnt : 1u;
}

__device__ __forceinline__ void xcd_barrier(const XcdBarrier& b) {
    asm volatile("s_waitcnt vmcnt(0)" ::: "memory");
    __syncthreads();
    if (threadIdx.x == 0) {
        unsigned* bar = b.bar;
        __builtin_amdgcn_s_waitcnt(0);
        unsigned nloc = b.st[0], nx = b.st[1];
        if (nloc == 0u) { xcd_barrier_complete(bar, b.x, nloc, nx); b.st[0] = nloc; b.st[1] = nx; }
        const unsigned old = xb_add(&bar[XB_XSUB(b.x)], 1u);
        const unsigned gen = old / nloc;
        if (old + 1u == (gen + 1u) * nloc) {
            __builtin_amdgcn_fence(__ATOMIC_RELEASE, "agent");
            asm volatile("s_waitcnt vmcnt(0)" ::: "memory");
            const unsigned og = xb_add(&bar[XB_TOP], 1u);
            const unsigned tg = og / nx;
            if (og + 1u == (tg + 1u) * nx) xb_add(&bar[XB_TOPGEN], 1u);
            else XB_SPIN(xb_ld(&bar[XB_TOPGEN]) == tg, bar);
            __builtin_amdgcn_fence(__ATOMIC_ACQUIRE, "agent");
            xb_add(&bar[XB_XGEN(b.x)], 1u);
            asm volatile("s_waitcnt vmcnt(0)" ::: "memory");
        } else {
            XB_SPIN(xb_ld(&bar[XB_XGEN(b.x)]) == gen, bar);
            __builtin_amdgcn_fence(__ATOMIC_ACQUIRE, "agent");
            asm volatile("s_waitcnt vmcnt(0)" ::: "memory");
        }
    }
    __syncthreads();
}

__device__ __forceinline__ pg8::Gemm std_gemm(const void* A, int lda, const void* Bt, int K) {
    pg8::Gemm g; g.A = (const char*)A; g.B = (const char*)Bt; g.nt = K / 64; g.a_row = lda; g.a_seg = 16; g.a_kstep = 128; g.a_g = 0; g.ldb = K; g.b_g = 0; return g;
}
__global__ void __launch_bounds__(NWAVES * 64, 2) mk_fwd(Args args0) {
    extern __shared__ __attribute__((aligned(16))) unsigned char lds[];
    cg::grid_group grid = cg::this_grid();
    const int ph_lo = args0.ph_lo, ph_hi = args0.ph_hi;
    volatile LAS unsigned* MISC = (volatile LAS unsigned*)((LAS unsigned char*)lds + MISC_OFF + 8192);
    if (threadIdx.x < 32) MISC[threadIdx.x] = 0u;
    __syncthreads();
    (void)xcd_barrier_post((unsigned*)(args0.ws + WS_BAR), MISC + 8);
    for (int ph = ph_lo; ph < ph_hi; ++ph) {
        typedef const __attribute__((address_space(4))) Args* KArgs;
        KArgs kap = (KArgs)__builtin_amdgcn_kernarg_segment_ptr(); asm volatile("" : "+s"(kap));
        const Args& args = *(const Args*)kap;
        Ctx F; F.lds = (LAS unsigned char*)lds; F.tid = ltid(); F.lane = F.tid & 63; F.wave = __builtin_amdgcn_readfirstlane(F.tid >> 6);
        const int bx = lbid(); F.G = lgrid(); F.bid = bx; F.vcu = (F.G % 8 == 0) ? (bx % 8) * (F.G / 8) + bx / 8 : bx;
        F.gw = bx * NWAVES + F.wave; F.NGW = F.G * NWAVES;
        unsigned char* ws = args.ws; bf16_t* Wb = (bf16_t*)(ws + WS_W); const float* mod = (const float*)(ws + WS_MOD);
        float* SSb = (float*)(ws + WS_SS); const float* BIASb = (const float*)(ws + WS_BIAS);
#define NEXTNORM(ln, wn, dst) pg8::NextNorm{(bf16_t*)(dst), ((wn) ? args.in[5] : args.in[4]) + (ln) * 1024, mod + (size_t)(ln) * 4 * 6144 + (wn) * 3072 + 1024, SSb + (size_t)(2 * (ln) + (wn)) * TOK}
        const int kind = args.prog[ph][0], layer = args.prog[ph][1], aux = args.prog[ph][2], j = args.prog[ph][3] & 1, nobar = args.prog[ph][3] >> 7;
#ifndef PH_MASK
#define PH_MASK 0xffffffffu
#endif
#define EN(k) (((PH_MASK) >> (k)) & 1u)
        switch (kind) {
        case K_PRO: if (EN(K_PRO)) { phase_prologue(F, args); } break;
        case K_MODRED: if (EN(K_MODRED)) { phase_modred(F, args); } break;
        case K_NORMMOD: if (EN(K_NORMMOD)) { phase_normmod(F, args, layer, aux); if (layer == 0 && aux == 0) { phase_bias(F, args); phase_modred(F, args); } } break;
        case K_QKN: if (EN(K_QKN)) { phase_qknorm(F, args, j); } break;
        case K_ATT: if (EN(K_ATT)) { const attn_body::AttnTensors AT{(const attn_body::bf16*)(ws + R_QN), (const attn_body::bf16*)(ws + R_KN), (const attn_body::bf16*)(ws + R_VC), (attn_body::bf16*)(ws + (aux ? R_QKV : R_QN))};
            const attn_body::StaticOrder S((int)F.G, bx);
            if (F.wave >= 4) __builtin_amdgcn_s_setprio(1);
            attn_body::attn_phase<attn_body::StaticOrder>((char*)lds, AT, S);
            __builtin_amdgcn_s_setprio(0); } break;
        case K_FFNCONV: if (EN(K_FFNCONV)) { phase_ffnfix(F, args, layer); } break;
        case K_HCT: if (EN(K_HCT)) { phase_hyconvT(F, args); } break;
        case K_HFFT: if (EN(K_HFFT)) { phase_hyfft(F, args); } break;
        case K_HTR: if (EN(K_HTR)) { phase_hytr(F, args); } break;
        case K_S5PREP: if (EN(K_S5PREP)) { phase_s5prep(F, args); } break;
        case K_S5SCAN: if (EN(K_S5SCAN)) { phase_s5scan(F, args); } break;
        case K_FINAL: if (EN(K_FINAL)) { phase_final(F, args); } break;
        case K_GEMM_HIN: if (EN(K_GEMM_HIN)) {
            pg8::Gemm g = std_gemm(Wb + WO_HIN, 1024, ws + WS_H, 1024); pg8::Sched S{3072 / 256, TOK / 256, 1, F.G, bx};
            pg8::EpiBf16T E{(bf16_t*)(ws + R_UPRE), SSb + (size_t)(2 * layer) * TOK, BIASb + 22528};
            pg8::gemm_phase<pg8::EpiBf16T>(F.lds, g, S, E); } break;
        case K_GEMM_WO: case K_GEMM_DN: case K_GEMM_HOUT: if (EN(K_GEMM_WO)) {
            pg8::Gemm g; pg8::Sched S; pg8::EpiRes E;
            if (kind == K_GEMM_WO) { g = std_gemm(ws + R_QN, 1024, Wb + WO_WO(j), 1024); S = pg8::Sched{TOK / 256, 4, 1, F.G, bx}; E = pg8::EpiRes{args.out, mod + (size_t)layer * 4 * 6144 + 2048, 0, NEXTNORM(layer, 1, ws + WS_H), layer == 0 ? args.in[0] : args.out}; }
            else if (kind == K_GEMM_HOUT) { g = std_gemm(ws + R_Z2T, 1024, Wb + WO_HOUT, 1024); S = pg8::Sched{TOK / 256, 4, 1, F.G, bx}; E = pg8::EpiRes{args.out, mod + (size_t)layer * 4 * 6144 + 2048, 0, NEXTNORM(layer, 1, ws + R_H2), args.out}; }
            else { g = std_gemm(ws + R_G, DFF, Wb + WO_DN(layer), DFF); S = pg8::Sched{TOK / 256, 4, 1, F.G, bx}; E = pg8::EpiRes{args.out, mod + (size_t)layer * 4 * 6144 + 5120, 0, pg8::NextNorm{nullptr, nullptr, nullptr, nullptr}, args.out};
                if (layer < 3) { E.nn = NEXTNORM(layer + 1, 0, ws + WS_H); if (layer == 1) { E.nn.Hn = nullptr; E.nn.ssn = nullptr; } } }
            if (aux) { E.X = (float*)(ws + WS_R + 200 * MiB); E.Xr = E.X; }
            pg8::gemm_phase<pg8::EpiRes>(F.lds, g, S, E); } break;
        case K_GEMM_QKV: if (EN(K_GEMM_QKV)) { pg8::Gemm g = std_gemm(ws + WS_H, 1024, Wb + WO_QKV(j), 1024); pg8::Sched S{TOK / 256, NQKV / 256, 1, F.G, bx};
            pg8::EpiQkv E{(bf16_t*)(ws + R_QN), (bf16_t*)(ws + R_KN), (bf16_t*)(ws + R_VC), SSb + (size_t)(2 * layer) * TOK, layer == 0 ? SSb + (size_t)4 * TOK : BIASb + 25600, layer == 0 ? 0 : pg8::NBIAS,
                          args.in[9] + j * 64, args.in[10] + j * 64, (const f32x2*)(ws + WS_ROPE), (LAS float*)(F.lds + MISC_OFF + 1024), (LAS float*)(F.lds + MISC_OFF + 9216)};
            pg8::gemm_phase<pg8::EpiQkv>(F.lds, g, S, E); } break;
        case K_GEMM_UP: if (EN(K_GEMM_UP)) { pg8::Gemm g = std_gemm(layer == 1 ? ws + R_H2 : ws + WS_H, 1024, Wb + WO_UP(layer), 1024); pg8::Sched S{TOK / 256, 5632 / 256, 1, F.G, bx};
            pg8::EpiFfn E{(bf16_t*)(ws + R_G), (float*)(ws + R_HALO), args.in[32] + (size_t)layer * 3 * DFF, args.in[33] + (size_t)layer * DFF, (LAS float*)(F.lds + MISC_OFF + 1024), SSb + (size_t)(2 * layer + 1) * TOK, BIASb + (size_t)layer * 5632};
            pg8::gemm_phase<pg8::EpiFfn>(F.lds, g, S, E); } break;
        case K_GEMM_GLU: if (EN(K_GEMM_GLU)) { pg8::Gemm g = std_gemm(ws + R_YI, 1024, Wb + WO_GLU, 1024); pg8::Sched S{TOK / 256, 8, 1, F.G, bx}; pg8::EpiGlu E{args.out, mod + (size_t)layer * 4 * 6144 + 2048, NEXTNORM(layer, 1, ws + WS_H)};
            pg8::gemm_phase<pg8::EpiGlu>(F.lds, g, S, E); } break;
        case K_GEMM_S1: if (EN(K_GEMM_S1)) { pg8::Gemm g; g.A = (const char*)(ws + WS_H); g.B = (const char*)(ws + R_BT1); g.nt = 8; g.a_row = 32 * 1024; g.a_seg = 1024; g.a_kstep = 4 * 1024 * 2; g.a_g = 32; g.ldb = 512; g.b_g = (size_t)768 * 512 * 2;
            pg8::Sched S{4, 3, 64, F.G, bx}; pg8::EpiS1 E{(bf16_t*)(ws + R_YI), (float*)(ws + R_S)};
            pg8::gemm_phase<pg8::EpiS1>(F.lds, g, S, E); } break;
        case K_GEMM_S2: if (EN(K_GEMM_S2)) { pg8::Gemm g; g.A = (const char*)(ws + R_XC); g.B = (const char*)(ws + R_CM); g.nt = 4; g.a_row = 256; g.a_seg = 16; g.a_kstep = 128; g.a_g = (size_t)1024 * 256 * 2; g.ldb = 256; g.b_g = (size_t)512 * 256 * 2;
            pg8::Sched S{4, 2, 64, F.G, bx}; pg8::EpiS2 E{(bf16_t*)(ws + R_YI)};
            pg8::gemm_phase<pg8::EpiS2>(F.lds, g, S, E); } break;
        default: break;
        }
        if (ph + 1 < ph_hi && !nobar) { if (ph_hi < 0) grid.sync(); else { XcdBarrier bar; bar.bar = (unsigned*)(ws + WS_BAR); bar.x = xb_xcc_id(); bar.st = (volatile LAS unsigned*)((LAS unsigned char*)lds + MISC_OFF + 8192) + 8; xcd_barrier(bar); } } else if (nobar) __syncthreads();
    }
}

#ifndef MK_PER_PHASE
#define MK_PER_PHASE 0
#endif
extern "C" void kernel_launch(void* const* d_in, const int* in_sizes, int n_in, void* d_out, int out_size, void* d_ws, size_t ws_size, hipStream_t stream) {
    static int grid = 0;
    if (grid == 0) {
        if (n_in != 35 || out_size != TOK * DM || ws_size < WS_END) { fprintf(stderr, "kernel_launch: unexpected shapes (n_in %d out %d ws %zu)\n", n_in, out_size, ws_size); grid = -1; return; }
        int dev = 0, cus = 0, per_cu = 0;
        hipGetDevice(&dev); hipDeviceGetAttribute(&cus, hipDeviceAttributeMultiprocessorCount, dev);
        if (hipFuncSetAttribute((const void*)mk_fwd, hipFuncAttributeMaxDynamicSharedMemorySize, LDS_BYTES) != hipSuccess) { fprintf(stderr, "kernel_launch: hipFuncSetAttribute failed\n"); grid = -1; return; }
        if (hipOccupancyMaxActiveBlocksPerMultiprocessor(&per_cu, (const void*)mk_fwd, NWAVES * 64, LDS_BYTES) != hipSuccess || per_cu < 1) { fprintf(stderr, "kernel_launch: occupancy query gave %d\n", per_cu); per_cu = 1; }
        (void)hipGetLastError();
        grid = cus * 1;
    }
    if (grid < 0) return;
    Args a{};
    for (int i = 0; i < 35; ++i) a.in[i] = (const float*)d_in[i];
    a.out = (float*)d_out; a.ws = (unsigned char*)d_ws;
    int np = 0;
#ifndef PROBE_DUP
#define PROBE_DUP 0u
#endif
    auto P1 = [&](int kind, int layer, int aux, int j) { a.prog[np][0] = (unsigned char)kind; a.prog[np][1] = (unsigned char)layer; a.prog[np][2] = (unsigned char)aux; a.prog[np][3] = (unsigned char)j; ++np; };
    auto P = [&](int kind, int layer, int aux, int j) { if ((PROBE_DUP >> kind) & 1u) P1(kind, layer, (kind == K_ATT || kind == K_GEMM_WO || kind == K_GEMM_DN || kind == K_GEMM_HOUT) ? 1 : aux, j); P1(kind, layer, aux, j); };
    P(K_PRO, 0, 0, 0);
    for (int i = 0; i < 4; ++i) {
        const int m = i % 3, j = i / 3;
        if (m == 0) { if (i == 0) P(K_NORMMOD, i, 0, j); P(K_GEMM_QKV, i, 0, j); P(K_ATT, i, 0, j); P(K_GEMM_WO, i, 0, j); }
        else if (m == 1) { P(K_GEMM_HIN, i, 0, j); P(K_HFFT, i, 0, j); P(K_HTR, i, 0, j); P(K_GEMM_HOUT, i, 0, j); }
        else { P(K_NORMMOD, i, 0, j | 128); P(K_S5PREP, i, 0, j); P(K_GEMM_S1, i, 0, j);   P(K_S5SCAN, i, 0, j); P(K_GEMM_S2, i, 0, j); P(K_GEMM_GLU, i, 0, j); }
        P(K_GEMM_UP, i, 0, j); P(K_FFNCONV, i, 0, j); P(K_GEMM_DN, i, 0, j);
    }
    P(K_FINAL, 0, 0, 0);
#if MK_PER_PHASE
    for (int ph = 0; ph < np; ++ph) { a.ph_lo = ph; a.ph_hi = ph + 1; hipLaunchKernelGGL(mk_fwd, dim3(grid), dim3(NWAVES * 64), LDS_BYTES, stream, a); }
#else
    a.ph_lo = 0; a.ph_hi = np;
    (void)hipMemsetAsync((char*)d_ws + WS_MOD, 0, 4 * 4 * 6144 * 4 + 16384, stream);
    void* kargs[] = {&a};
    hipError_t e = hipLaunchCooperativeKernel((const void*)mk_fwd, dim3(grid), dim3(NWAVES * 64), kargs, LDS_BYTES, stream);
    if (e != hipSuccess) fprintf(stderr, "kernel_launch: cooperative launch failed: %s (grid %d)\n", hipGetErrorString(e), grid);
#endif
}
```

```cpp
#include <hip/hip_runtime.h>
#include <hip/hip_cooperative_groups.h>
#include <hip/hip_bf16.h>
#include <cstdio>
#include <cstdint>
#include <cmath>
namespace cg = cooperative_groups;

#define LAS __attribute__((address_space(3)))
typedef unsigned short bf16_t;
typedef short bf16x8 __attribute__((ext_vector_type(8)));
typedef float f32x4 __attribute__((ext_vector_type(4)));
typedef float f32x2 __attribute__((ext_vector_type(2)));
typedef unsigned u32x4 __attribute__((ext_vector_type(4)));
typedef unsigned u32x2 __attribute__((ext_vector_type(2)));

constexpr int NB = 4, SEQ = 8192, DM = 1024, TOK = NB * SEQ, DFF = 2816, NHEAD = 16, NKV = 4, HD = 64, NQKV = 1536;
constexpr float EPS = 1e-6f;
constexpr int NWAVES = 8;

__device__ __forceinline__ unsigned f2bf(float f) { unsigned u = __builtin_bit_cast(unsigned, f); return (u + 0x7fffu + ((u >> 16) & 1u)) >> 16; }
__device__ __forceinline__ unsigned pk2(float lo, float hi) { return f2bf(lo) | (f2bf(hi) << 16); }
__device__ __forceinline__ float bf2f(unsigned short b) { return __builtin_bit_cast(float, (unsigned)b << 16); }
__device__ __forceinline__ float bflo(unsigned w) { return __builtin_bit_cast(float, w << 16); }
__device__ __forceinline__ float bfhi(unsigned w) { return __builtin_bit_cast(float, w & 0xffff0000u); }
__device__ __forceinline__ float bperm(float v, int srclane) { return __builtin_bit_cast(float, __builtin_amdgcn_ds_bpermute(srclane << 2, __builtin_bit_cast(int, v))); }
__device__ __forceinline__ float dpp_rotr1(float v) { return __builtin_bit_cast(float, __builtin_amdgcn_update_dpp(0, __builtin_bit_cast(int, v), 0x121, 0xf, 0xf, true)); }
__device__ __forceinline__ float dpp_rotl1(float v) { return __builtin_bit_cast(float, __builtin_amdgcn_update_dpp(0, __builtin_bit_cast(int, v), 0x12F, 0xf, 0xf, true)); }
__device__ __forceinline__ float dpp_shr1(float edge, float v) { return __builtin_bit_cast(float, __builtin_amdgcn_update_dpp(__builtin_bit_cast(int, edge), __builtin_bit_cast(int, v), 0x111, 0xf, 0xf, false)); }
__device__ __forceinline__ float dpp_shl1(float edge, float v) { return __builtin_bit_cast(float, __builtin_amdgcn_update_dpp(__builtin_bit_cast(int, edge), __builtin_bit_cast(int, v), 0x101, 0xf, 0xf, false)); }
__device__ __forceinline__ float wave_sum(float v, int lane) {
#pragma unroll
    for (int o = 1; o < 64; o <<= 1) v += bperm(v, lane ^ o);
    return v;
}
__device__ __forceinline__ int ltid() { int t = threadIdx.x; asm volatile("" : "+v"(t)); return t; }
__device__ __forceinline__ int lbid() { int b = blockIdx.x; asm volatile("" : "+s"(b)); return b; }
__device__ __forceinline__ int lgrid() { int g = gridDim.x; asm volatile("" : "+s"(g)); return g; }
__device__ __forceinline__ float sigmoidf_(float x) { return __builtin_amdgcn_rcpf(1.0f + __builtin_amdgcn_exp2f(x * -1.4426950408889634f)); }
__device__ __forceinline__ float gelu_tanh(float x) { const float u = 0.7978845608028654f * (x + 0.044715f * x * x * x); return x * sigmoidf_(2.0f * u); }

namespace pg8 {
constexpr int BM = 256, BK = 64, HALF = 128, HTB = HALF * BK * 2, STAGE_BYTES = 8 * HTB, NXCD = 8, WGM = 8;
__host__ __device__ __forceinline__ int lds_byte(int r, int c) { const int st = (r >> 4) * 2 + (c >> 5), rr = r & 15, cc = c & 31, ob = rr * 64 + cc * 2; return st * 1024 + (ob ^ (((ob >> 9) & 1) << 5)); }
__host__ __device__ __forceinline__ void stage_rc(int b, int& R, int& C) { const int st = b / 1024, sb = b % 1024, swz = sb ^ (((sb >> 9) & 1) << 5); R = (st >> 1) * 16 + swz / 64; C = (st & 1) * 32 + (swz % 64) / 2; }
__host__ __device__ __forceinline__ int perm32(int rho) { const int n = rho >> 4, i = rho & 15; return 8 * (i >> 2) + 4 * n + (i & 3); }

struct Unit { int pm, pn, g; };
struct Gemm { const char* A; const char* B; int nt; int a_row, a_seg; size_t a_kstep, a_g; int ldb; size_t b_g; };
struct Sched {
    int nM, nN, ng, G, c;
    __device__ __forceinline__ bool next(int i, Unit& u) const {
        const long L = (long)i * G + c; const int per = nM * nN; if (L >= (long)per * ng) return false;
        if (ng == 1) {
            int wgid = (int)L; { const int q = per / NXCD, r = per % NXCD, xcd = wgid % NXCD, off = wgid / NXCD; wgid = (xcd < r ? xcd * (q + 1) : r * (q + 1) + (xcd - r) * q) + off; }
            const int nig = WGM * nN, gid = wgid / nig, fm = gid * WGM, gsz = (nM - fm) < WGM ? (nM - fm) : WGM;
            u.pm = fm + ((wgid % nig) % gsz); u.pn = (wgid % nig) / gsz; u.g = 0;
        } else { u.g = (int)(L / per); const int r = (int)(L - (long)u.g * per); u.pm = r % nM; u.pn = r / nM; }
        return true;
    }
};
__device__ __forceinline__ unsigned cvt_pk_bf16(float lo, float hi) { unsigned r; asm volatile("v_cvt_pk_bf16_f32 %0, %1, %2" : "=v"(r) : "v"(lo), "v"(hi)); return r; }

constexpr int NBIAS = 27136;
__device__ __forceinline__ void apply_rstd_bias(f32x4 (&acc)[2][2][4][2], const float* ss, const float* bias, int rowt, int colt, bool perm, int wr, int wc, int fr, int fq, int bstride = NBIAS) {
    const int b = rowt / SEQ; const float* bp = bias + (size_t)b * bstride + colt + wc * 32 + (perm ? 8 * fq : 4 * fq);
    float rs[2][4];
#pragma unroll
    for (int ai = 0; ai < 2; ++ai)
#pragma unroll
        for (int m = 0; m < 4; ++m) rs[ai][m] = __builtin_amdgcn_rsqf(ss[rowt + ai * HALF + wr * 64 + m * 16 + fr] * (1.0f / DM) + EPS);
#pragma unroll
    for (int bj = 0; bj < 2; ++bj)
#pragma unroll
        for (int n = 0; n < 2; ++n) { const f32x4 bv = *(const f32x4*)(bp + bj * HALF + (perm ? 4 * n : 16 * n));
#pragma unroll
            for (int ai = 0; ai < 2; ++ai)
#pragma unroll
                for (int m = 0; m < 4; ++m) acc[ai][bj][m][n] = acc[ai][bj][m][n] * rs[ai][m] + bv; }
}
struct EpiBf16 {
    static constexpr bool PERM = true;
    bf16_t* O; int ldc; const float* ss; const float* bias; int bstride;
    __device__ __forceinline__ void operator()(f32x4 (&acc)[2][2][4][2], const Unit& u, int wr, int wc, int fr, int fq) const {
        apply_rstd_bias(acc, ss, bias, u.pm * BM, u.pn * BM, true, wr, wc, fr, fq, bstride);
        asm volatile("" ::: "memory"); __builtin_amdgcn_sched_barrier(0);
        const int row0 = u.pm * BM + wr * 64 + fr; const int col0 = u.pn * BM + wc * 32 + 8 * fq;
#pragma unroll
        for (int ai = 0; ai < 2; ++ai)
#pragma unroll
            for (int m = 0; m < 4; ++m) { bf16_t* rowp = O + (size_t)(row0 + ai * HALF + m * 16) * ldc + col0;
#pragma unroll
                for (int bj = 0; bj < 2; ++bj) { const f32x4 v0 = acc[ai][bj][m][0], v1 = acc[ai][bj][m][1];
                    u32x4 w; w.x = cvt_pk_bf16(v0[0], v0[1]); w.y = cvt_pk_bf16(v0[2], v0[3]); w.z = cvt_pk_bf16(v1[0], v1[1]); w.w = cvt_pk_bf16(v1[2], v1[3]);
                    *(u32x4*)(rowp + bj * HALF) = w; } }
    }
};
struct EpiBf16T {
    static constexpr bool PERM = true;
    bf16_t* O; const float* ss; const float* bias;
    __device__ __forceinline__ void operator()(f32x4 (&acc)[2][2][4][2], const Unit& u, int wr, int wc, int fr_, int fq_) const {
        int fr = fr_, fq = fq_; asm volatile("" : "+v"(fr), "+v"(fq));
        const int tok0 = u.pn * BM + wc * 32 + 8 * fq; const int b = (u.pn * BM) / SEQ; const float* bp = bias + (size_t)b * NBIAS;
        f32x4 rs[2][2];
#pragma unroll
        for (int bj = 0; bj < 2; ++bj)
#pragma unroll
            for (int n = 0; n < 2; ++n) { const f32x4 sv = *(const f32x4*)(ss + tok0 + bj * HALF + 4 * n);
#pragma unroll
                for (int e = 0; e < 4; ++e) rs[bj][n][e] = __builtin_amdgcn_rsqf(sv[e] * (1.0f / DM) + EPS); }
#pragma unroll
        for (int ai = 0; ai < 2; ++ai)
#pragma unroll
            for (int m = 0; m < 4; ++m) { const int c = u.pm * BM + ai * HALF + wr * 64 + m * 16 + fr; const float bv = bp[c];
#pragma unroll
                for (int bj = 0; bj < 2; ++bj) { const f32x4 v0 = acc[ai][bj][m][0] * rs[bj][0] + bv, v1 = acc[ai][bj][m][1] * rs[bj][1] + bv;
                    *(u32x4*)(O + (size_t)c * TOK + tok0 + bj * HALF) = (u32x4){cvt_pk_bf16(v0[0], v0[1]), cvt_pk_bf16(v0[2], v0[3]), cvt_pk_bf16(v1[0], v1[1]), cvt_pk_bf16(v1[2], v1[3])}; } }
    }
};
struct EpiQkv {
    static constexpr bool PERM = true;
    bf16_t* Qn; bf16_t* Kn; bf16_t* Vc; const float* ss; const float* bias; int bstride; const float* qg; const float* kg; const f32x2* rope; LAS float* xch0; LAS float* xch1;
    __device__ __forceinline__ void operator()(f32x4 (&acc)[2][2][4][2], const Unit& u, int wr, int wc, int fr_, int fq_) const {
        int fr = fr_, fq = fq_; asm volatile("" : "+v"(fr), "+v"(fq));
        apply_rstd_bias(acc, ss, bias, u.pm * BM, u.pn * BM, true, wr, wc, fr, fq, bstride);
        asm volatile("" ::: "memory"); __builtin_amdgcn_sched_barrier(0);
        const int lane = fq * 16 + fr; const int cw = wc * 32 + 8 * fq;
        if (u.pn == 5) {
#pragma unroll
            for (int ai = 0; ai < 2; ++ai)
#pragma unroll
                for (int m = 0; m < 4; ++m) { const int r = u.pm * BM + ai * HALF + wr * 64 + m * 16 + fr;
#pragma unroll
                    for (int bj = 0; bj < 2; ++bj) { const f32x4 v0 = acc[ai][bj][m][0], v1 = acc[ai][bj][m][1];
                        *(u32x4*)(Vc + (size_t)r * 256 + bj * HALF + cw) = (u32x4){cvt_pk_bf16(v0[0], v0[1]), cvt_pk_bf16(v0[2], v0[3]), cvt_pk_bf16(v1[0], v1[1]), cvt_pk_bf16(v1[2], v1[3])}; } }
            return;
        }
#pragma unroll
        for (int ai = 0; ai < 2; ++ai)
#pragma unroll
            for (int m = 0; m < 4; ++m)
#pragma unroll
                for (int bj = 0; bj < 2; ++bj) { const f32x4 v0 = acc[ai][bj][m][0], v1 = acc[ai][bj][m][1];
                    float sq = (v0.x * v0.x + v0.y * v0.y) + (v0.z * v0.z + v0.w * v0.w) + (v1.x * v1.x + v1.y * v1.y) + (v1.z * v1.z + v1.w * v1.w);
                    sq += bperm(sq, lane ^ 16); sq += bperm(sq, lane ^ 32);
                    if (fq == 0) (bj ? xch1 : xch0)[(ai * HALF + wr * 64 + m * 16 + fr) * 4 + wc] = sq; }
        asm volatile("s_waitcnt lgkmcnt(0)" ::: "memory"); __builtin_amdgcn_s_barrier(); asm volatile("" ::: "memory");
        const bool isq = (u.pn < 4); const float* gp = (isq ? qg : kg) + (wc & 1) * 32 + 8 * fq;
        const f32x4 g0 = *(const f32x4*)gp, g1 = *(const f32x4*)(gp + 4);
        const float C2 = isq ? 0.125f * 1.4426950408889634f : 1.0f;
        const int pi0 = (wc & 1) * 16 + 4 * fq;
#pragma unroll
        for (int ai = 0; ai < 2; ++ai)
#pragma unroll
            for (int m = 0; m < 4; ++m) { const int rt = ai * HALF + wr * 64 + m * 16 + fr; const int r = u.pm * BM + rt; const int t = r & (SEQ - 1);
                const f32x4 cs0 = *(const f32x4*)(rope + (size_t)t * 32 + pi0), cs1 = *(const f32x4*)(rope + (size_t)t * 32 + pi0 + 2);
#pragma unroll
                for (int bj = 0; bj < 2; ++bj) { LAS float* xc = bj ? xch1 : xch0;
                    const float tot = xc[rt * 4 + wc] + xc[rt * 4 + (wc ^ 1)];
                    const float rs = __builtin_amdgcn_rsqf(tot * (1.0f / 64.0f) + EPS) * C2;
                    const f32x4 v0 = acc[ai][bj][m][0] * g0 * rs, v1 = acc[ai][bj][m][1] * g1 * rs;
                    const float o0 = v0.x * cs0.x - v0.y * cs0.y, o1 = v0.x * cs0.y + v0.y * cs0.x, o2 = v0.z * cs0.z - v0.w * cs0.w, o3 = v0.z * cs0.w + v0.w * cs0.z;
                    const float o4 = v1.x * cs1.x - v1.y * cs1.y, o5 = v1.x * cs1.y + v1.y * cs1.x, o6 = v1.z * cs1.z - v1.w * cs1.w, o7 = v1.z * cs1.w + v1.w * cs1.z;
                    const u32x4 w = {cvt_pk_bf16(o0, o1), cvt_pk_bf16(o2, o3), cvt_pk_bf16(o4, o5), cvt_pk_bf16(o6, o7)};
                    if (isq) *(u32x4*)(Qn + (size_t)r * 1024 + u.pn * BM + bj * HALF + cw) = w; else *(u32x4*)(Kn + (size_t)r * 256 + bj * HALF + cw) = w; }
                asm volatile("" ::: "memory"); }
    }
};
__device__ __forceinline__ float shfl_xor_l(float v, int mask, int lane) { return bperm(v, lane ^ mask); }
struct NextNorm { bf16_t* Hn; const float* gn; const float* scn; float* ssn; };
struct EpiRes {
    static constexpr bool PERM = true;
    float* X; const float* gate; int rowoff; NextNorm nn; const float* Xr;
    __device__ __forceinline__ void operator()(f32x4 (&acc)[2][2][4][2], const Unit& u, int wr, int wc, int fr, int fq) const {
        const int rbase = rowoff + u.pm * BM; const int b = rbase / SEQ; const float* gp = gate + (size_t)b * 6144;
        const int row0 = rbase + wr * 64 + fr, col0 = u.pn * BM + wc * 32 + 8 * fq;
#pragma unroll
        for (int ai = 0; ai < 2; ++ai)
#pragma unroll
            for (int mh = 0; mh < 2; ++mh) {
                f32x4 xv[2][2][2], gv[2][2];
#pragma unroll
                for (int mm = 0; mm < 2; ++mm) { const float* p = Xr + (size_t)(row0 + ai * HALF + (2 * mh + mm) * 16) * DM + col0;
#pragma unroll
                    for (int bj = 0; bj < 2; ++bj)
#pragma unroll
                        for (int n = 0; n < 2; ++n) xv[mm][bj][n] = *(const f32x4*)(p + bj * HALF + n * 4); }
#pragma unroll
                for (int bj = 0; bj < 2; ++bj)
#pragma unroll
                    for (int n = 0; n < 2; ++n) gv[bj][n] = *(const f32x4*)(gp + col0 + bj * HALF + n * 4);
                float sq[2] = {0.f, 0.f};
#pragma unroll
                for (int mm = 0; mm < 2; ++mm) { const int r = row0 + ai * HALF + (2 * mh + mm) * 16; float* p = X + (size_t)r * DM + col0;
#pragma unroll
                    for (int bj = 0; bj < 2; ++bj)
#pragma unroll
                        for (int n = 0; n < 2; ++n) { const f32x4 xn = xv[mm][bj][n] + gv[bj][n] * acc[ai][bj][2 * mh + mm][n]; *(f32x4*)(p + bj * HALF + n * 4) = xn; xv[mm][bj][n] = xn;
                            sq[mm] += (xn.x * xn.x + xn.y * xn.y) + (xn.z * xn.z + xn.w * xn.w); } }
                if (nn.ssn) {
#pragma unroll
                    for (int mm = 0; mm < 2; ++mm) { const int r = row0 + ai * HALF + (2 * mh + mm) * 16; float q = sq[mm]; q += shfl_xor_l(q, 16, fq * 16 + fr); q += shfl_xor_l(q, 32, fq * 16 + fr); if (fq == 0) atomicAdd(nn.ssn + r, q); }
                    if (nn.Hn) {
#pragma unroll
                        for (int bj = 0; bj < 2; ++bj) { const float* gq = nn.gn + col0 + bj * HALF; const float* sp = nn.scn + (size_t)b * 6144 + col0 + bj * HALF;
                            const f32x4 c0 = *(const f32x4*)gq * (*(const f32x4*)sp + 1.0f), c1 = *(const f32x4*)(gq + 4) * (*(const f32x4*)(sp + 4) + 1.0f);
#pragma unroll
                            for (int mm = 0; mm < 2; ++mm) { const int r = row0 + ai * HALF + (2 * mh + mm) * 16; const f32x4 h0 = xv[mm][bj][0] * c0, h1 = xv[mm][bj][1] * c1;
                                *(u32x4*)(nn.Hn + (size_t)r * DM + col0 + bj * HALF) = (u32x4){cvt_pk_bf16(h0.x, h0.y), cvt_pk_bf16(h0.z, h0.w), cvt_pk_bf16(h1.x, h1.y), cvt_pk_bf16(h1.z, h1.w)}; } } } }
                asm volatile("" ::: "memory"); }
    }
};
struct EpiGlu {
    static constexpr bool PERM = true;
    float* X; const float* gate; NextNorm nn;
    __device__ __forceinline__ void operator()(f32x4 (&acc)[2][2][4][2], const Unit& u, int wr, int wc, int fr, int fq) const {
        const int rbase = u.pm * BM; const int b = rbase / SEQ; const float* gp = gate + (size_t)b * 6144;
        const int row0 = rbase + wr * 64 + fr, col0 = u.pn * HALF + wc * 32 + 8 * fq;
        f32x4 gv[2], cs[2];
#pragma unroll
        for (int n = 0; n < 2; ++n) { gv[n] = *(const f32x4*)(gp + col0 + n * 4); cs[n] = *(const f32x4*)(nn.gn + col0 + n * 4) * (*(const f32x4*)(nn.scn + (size_t)b * 6144 + col0 + n * 4) + 1.0f); }
#pragma unroll
        for (int ai = 0; ai < 2; ++ai) {
            f32x4 xv[4][2];
#pragma unroll
            for (int m = 0; m < 4; ++m) { const float* p = X + (size_t)(row0 + ai * HALF + m * 16) * DM + col0;
#pragma unroll
                for (int n = 0; n < 2; ++n) xv[m][n] = *(const f32x4*)(p + n * 4); }
#pragma unroll
            for (int m = 0; m < 4; ++m) { const int r = row0 + ai * HALF + m * 16; float* p = X + (size_t)r * DM + col0; float sq = 0.f; f32x4 hv[2];
#pragma unroll
                for (int n = 0; n < 2; ++n) { f32x4 x4 = xv[m][n]; const f32x4 ga = acc[ai][0][m][n], gb = acc[ai][1][m][n];
#pragma unroll
                    for (int e = 0; e < 4; ++e) x4[e] += gv[n][e] * ga[e] * sigmoidf_(gb[e]);
                    *(f32x4*)(p + n * 4) = x4; sq += (x4.x * x4.x + x4.y * x4.y) + (x4.z * x4.z + x4.w * x4.w); hv[n] = x4 * cs[n]; }
                *(u32x4*)(nn.Hn + (size_t)r * DM + col0) = (u32x4){cvt_pk_bf16(hv[0].x, hv[0].y), cvt_pk_bf16(hv[0].z, hv[0].w), cvt_pk_bf16(hv[1].x, hv[1].y), cvt_pk_bf16(hv[1].z, hv[1].w)};
                sq += shfl_xor_l(sq, 16, fq * 16 + fr); sq += shfl_xor_l(sq, 32, fq * 16 + fr); if (fq == 0) atomicAdd(nn.ssn + r, sq); }
            asm volatile("" ::: "memory"); }
    }
};
struct EpiS1 {
    static constexpr bool PERM = true;
    bf16_t* Yi; float* S;
    __device__ __forceinline__ void operator()(f32x4 (&acc)[2][2][4][2], const Unit& u, int wr, int wc, int fr, int fq) const {
        const int row0 = u.pm * BM + wr * 64 + fr; const int cw = wc * 32 + 8 * fq;
#pragma unroll
        for (int ai = 0; ai < 2; ++ai)
#pragma unroll
            for (int m = 0; m < 4; ++m) { const int r = row0 + ai * HALF + m * 16;
#pragma unroll
                for (int bj = 0; bj < 2; ++bj) { const f32x4 v0 = acc[ai][bj][m][0], v1 = acc[ai][bj][m][1]; const int c = u.pn * BM + bj * HALF + cw;
                    if (u.pn < 2) { u32x4 w; w.x = cvt_pk_bf16(v0[0], v0[1]); w.y = cvt_pk_bf16(v0[2], v0[3]); w.z = cvt_pk_bf16(v1[0], v1[1]); w.w = cvt_pk_bf16(v1[2], v1[3]);
                        *(u32x4*)(Yi + ((size_t)(r * 32 + (c >> 4)) * DM + u.g * 16 + (c & 15))) = w; }
                    else { float* sp = S + ((size_t)(u.g * 1024 + r) * 256 + (c - 512)); *(f32x4*)sp = v0; *(f32x4*)(sp + 4) = v1; } } }
    }
};
struct EpiS2 {
    static constexpr bool PERM = true;
    bf16_t* Yi;
    __device__ __forceinline__ void operator()(f32x4 (&acc)[2][2][4][2], const Unit& u, int wr, int wc, int fr, int fq) const {
        const int row0 = u.pm * BM + wr * 64 + fr; const int cw = wc * 32 + 8 * fq;
#pragma unroll
        for (int ai = 0; ai < 2; ++ai) {
            u32x4 yv[4][2];
#pragma unroll
            for (int m = 0; m < 4; ++m)
#pragma unroll
                for (int bj = 0; bj < 2; ++bj) { const int r = row0 + ai * HALF + m * 16, c = u.pn * BM + bj * HALF + cw; yv[m][bj] = *(const u32x4*)(Yi + ((size_t)(r * 32 + (c >> 4)) * DM + u.g * 16 + (c & 15))); }
#pragma unroll
            for (int m = 0; m < 4; ++m)
#pragma unroll
                for (int bj = 0; bj < 2; ++bj) { const int r = row0 + ai * HALF + m * 16, c = u.pn * BM + bj * HALF + cw; const f32x4 v0 = acc[ai][bj][m][0], v1 = acc[ai][bj][m][1]; const u32x4 yi = yv[m][bj];
                    u32x4 w;
                    w.x = cvt_pk_bf16(gelu_tanh(v0[0] + bflo(yi.x)), gelu_tanh(v0[1] + bfhi(yi.x)));
                    w.y = cvt_pk_bf16(gelu_tanh(v0[2] + bflo(yi.y)), gelu_tanh(v0[3] + bfhi(yi.y)));
                    w.z = cvt_pk_bf16(gelu_tanh(v1[0] + bflo(yi.z)), gelu_tanh(v1[1] + bfhi(yi.z)));
                    w.w = cvt_pk_bf16(gelu_tanh(v1[2] + bflo(yi.w)), gelu_tanh(v1[3] + bfhi(yi.w)));
                    *(u32x4*)(Yi + ((size_t)(r * 32 + (c >> 4)) * DM + u.g * 16 + (c & 15))) = w; }
            asm volatile("" ::: "memory"); }
    }
};

struct EpiFfn {
    static constexpr bool PERM = true;
    bf16_t* G; float* halo; const float* cw; const float* cb; LAS float* edge; const float* ss; const float* bias;
    __device__ __forceinline__ void operator()(f32x4 (&acc)[2][2][4][2], const Unit& u, int wr, int wc, int fr, int fq) const {
        f32x4 cwv[2][4];
        { const int cq = u.pn * HALF + wc * 32 + 8 * fq;
#pragma unroll
          for (int n = 0; n < 2; ++n) { cwv[n][0] = *(const f32x4*)(cw + cq + 4 * n); cwv[n][1] = *(const f32x4*)(cw + DFF + cq + 4 * n); cwv[n][2] = *(const f32x4*)(cw + 2 * DFF + cq + 4 * n); cwv[n][3] = *(const f32x4*)(cb + cq + 4 * n); } }
        apply_rstd_bias(acc, ss, bias, u.pm * BM, u.pn * BM, true, wr, wc, fr, fq);
        asm volatile("" ::: "memory"); __builtin_amdgcn_sched_barrier(0);
        const int lane = fq * 16 + fr; const int cl = wc * 32 + 8 * fq;
        const int col0 = u.pn * HALF + cl;
        if (fr == 0) {
#pragma unroll
            for (int ai = 0; ai < 2; ++ai) { *(LAS f32x4*)(edge + ((wr * 2 + ai) * 2 + 0) * 128 + cl) = acc[ai][0][0][0]; *(LAS f32x4*)(edge + ((wr * 2 + ai) * 2 + 0) * 128 + cl + 4) = acc[ai][0][0][1]; } }
        if (fr == 15) {
#pragma unroll
            for (int ai = 0; ai < 2; ++ai) { *(LAS f32x4*)(edge + ((wr * 2 + ai) * 2 + 1) * 128 + cl) = acc[ai][0][3][0]; *(LAS f32x4*)(edge + ((wr * 2 + ai) * 2 + 1) * 128 + cl + 4) = acc[ai][0][3][1]; } }
        { float* hp = halo + (size_t)u.pm * 6 * DFF + col0;
          if (wr == 0 && fr < 2) { *(f32x4*)(hp + fr * DFF) = acc[0][0][0][0]; *(f32x4*)(hp + fr * DFF + 4) = acc[0][0][0][1]; if (fr == 0) { *(f32x4*)(hp + 4 * DFF) = acc[0][1][0][0]; *(f32x4*)(hp + 4 * DFF + 4) = acc[0][1][0][1]; } }
          if (wr == 1 && fr >= 14) { *(f32x4*)(hp + (fr - 12) * DFF) = acc[1][0][3][0]; *(f32x4*)(hp + (fr - 12) * DFF + 4) = acc[1][0][3][1]; if (fr == 15) { *(f32x4*)(hp + 5 * DFF) = acc[1][1][3][0]; *(f32x4*)(hp + 5 * DFF + 4) = acc[1][1][3][1]; } } }
        asm volatile("s_waitcnt lgkmcnt(0)" ::: "memory"); __builtin_amdgcn_s_barrier(); asm volatile("" ::: "memory");
        const int srcR = (lane & 48) | ((fr + 15) & 15), srcL = (lane & 48) | ((fr + 1) & 15);
        const int ow = wr ^ 1;
        u32x2 stash[2][4];
#pragma unroll
        for (int n = 0; n < 2; ++n) {
            const int cc = col0 + 4 * n;
            const f32x4 w0 = cwv[n][0], w1 = cwv[n][1], w2 = cwv[n][2], bb = cwv[n][3];
#pragma unroll
            for (int ai = 0; ai < 2; ++ai) {
                const int pa = (wr == 0) ? ai - 1 : ai, na = (wr == 0) ? ai : ai + 1;
                const f32x4 eP = (pa >= 0) ? *(const LAS f32x4*)(edge + ((ow * 2 + pa) * 2 + 1) * 128 + cl + 4 * n) : (f32x4){0.f, 0.f, 0.f, 0.f};
                const f32x4 eN = (na <= 1) ? *(const LAS f32x4*)(edge + ((ow * 2 + na) * 2 + 0) * 128 + cl + 4 * n) : (f32x4){0.f, 0.f, 0.f, 0.f};
                f32x4 Rprev = eP;
#pragma unroll
                for (int m = 0; m < 4; ++m) {
                    const int rt = ai * HALF + wr * 64 + m * 16 + fr;
                    f32x4 Rm, Ln; float o[4];
#pragma unroll
                    for (int e = 0; e < 4; ++e) { Rm[e] = dpp_rotr1(acc[ai][0][m][n][e]); Ln[e] = (m < 3) ? dpp_rotl1(acc[ai][0][m < 3 ? m + 1 : 3][n][e]) : eN[e]; }
#pragma unroll
                    for (int e = 0; e < 4; ++e) {
                        const float cur = acc[ai][0][m][n][e];
                        const float pv = dpp_shr1(Rprev[e], cur), nv = dpp_shl1(Ln[e], cur);
                        const float gt = pv * w0[e] + cur * w1[e] + nv * w2[e] + bb[e];
                        o[e] = gt * sigmoidf_(gt) * acc[ai][1][m][n][e]; }
                    const u32x2 pkd = {cvt_pk_bf16(o[0], o[1]), cvt_pk_bf16(o[2], o[3])};
                    if (n == 0) stash[ai][m] = pkd;
                    else if (rt != 0 && rt != 255) *(u32x4*)(G + (size_t)(u.pm * BM + rt) * DFF + col0) = (u32x4){stash[ai][m].x, stash[ai][m].y, pkd.x, pkd.y};
                    Rprev = Rm; asm volatile("" ::: "memory");
                }
            }
        }
    }
};

template <class Epi>
__device__ __forceinline__ void gemm_phase(LAS unsigned char* lds, const Gemm g, const Sched& S, const Epi& E) {
    const int tid = ltid(), wid = __builtin_amdgcn_readfirstlane(tid >> 6), lane = tid & 63, wr = wid >> 2, wc = wid & 3, fr = lane & 15, fq = lane >> 4;
    int nt = g.nt; asm volatile("" : "+s"(nt));
    unsigned voffA[2], voffB[2];
#pragma unroll
    for (int i = 0; i < 2; ++i) { int R, C; stage_rc(tid * 16 + i * 8192, R, C); const int Rb = Epi::PERM ? ((R & ~31) + perm32(R & 31)) : R;
        voffA[i] = (unsigned)(R * g.a_row + (C >> 4) * g.a_seg + (C & 15)) * 2u; voffB[i] = (unsigned)(Rb * g.ldb + C) * 2u; }
    const size_t kA = g.a_kstep, kB = (size_t)(BK * 2);
    const size_t hA = (size_t)HALF * g.a_row * 2, hB = (size_t)HALF * g.ldb * 2, tA = 2 * hA, tB = 2 * hB;
    const unsigned ldsw = (unsigned)wid * 1024u;
    const int aoff = lds_byte(wr * 64 + fr, fq * 8), boff = lds_byte(wc * 32 + fr, fq * 8);
#define PG8_SA(b, h) (((b) * 2 + (h)) * HTB)
#define PG8_SB(b, h) ((4 + (b) * 2 + (h)) * HTB)
#define PG8_STAGE(bufoff, gbase, voff) do { _Pragma("unroll") for (int _i = 0; _i < 2; ++_i) \
        __builtin_amdgcn_global_load_lds((const unsigned*)((const char*)(gbase) + (voff)[_i]), (LAS unsigned*)(lds + (bufoff) + ldsw + _i * 8192), 16, 0, 0); } while (0)
#define PG8_LDA(dst, b, h) do { _Pragma("unroll") for (int m = 0; m < 4; ++m) _Pragma("unroll") for (int k = 0; k < 2; ++k) dst[m][k] = *(const LAS bf16x8*)(lds + PG8_SA(b, h) + aoff + m * 2048 + k * 1024); } while (0)
#define PG8_LDB(dst, b, h) do { _Pragma("unroll") for (int n = 0; n < 2; ++n) _Pragma("unroll") for (int k = 0; k < 2; ++k) dst[n][k] = *(const LAS bf16x8*)(lds + PG8_SB(b, h) + boff + n * 2048 + k * 1024); } while (0)
#define PG8_MMA(ai, bj, At, Bt) do { __builtin_amdgcn_s_setprio(1); _Pragma("unroll") for (int m = 0; m < 4; ++m) _Pragma("unroll") for (int n = 0; n < 2; ++n) _Pragma("unroll") for (int k = 0; k < 2; ++k) \
        acc[ai][bj][m][n] = __builtin_amdgcn_mfma_f32_16x16x32_bf16(Bt[n][k], At[m][k], acc[ai][bj][m][n], 0, 0, 0); __builtin_amdgcn_s_setprio(0); } while (0)
#define PG8_WAIT_V(n) asm volatile("s_waitcnt vmcnt(" #n ")" ::: "memory")
#define PG8_WAIT_L(n) asm volatile("s_waitcnt lgkmcnt(" #n ")" ::: "memory")
#define PG8_BAR __builtin_amdgcn_s_barrier()
#define PG8_SCHED __builtin_amdgcn_sched_barrier(0)
    Unit cur, nxt; int ui = 0;
    if (!S.next(0, cur)) return;
    f32x4 acc[2][2][4][2];
#pragma unroll
    for (int a = 0; a < 2; ++a)
#pragma unroll
        for (int b = 0; b < 2; ++b)
#pragma unroll
            for (int m = 0; m < 4; ++m)
#pragma unroll
                for (int n = 0; n < 2; ++n) acc[a][b][m][n] = (f32x4){0.f, 0.f, 0.f, 0.f};
    bf16x8 At[4][2], B0[2][2], B1[2][2];
    const char* cA = g.A + (size_t)cur.g * g.a_g + (size_t)cur.pm * tA; const char* cB = g.B + (size_t)cur.g * g.b_g + (size_t)cur.pn * tB;
    PG8_STAGE(PG8_SB(0, 0), cB, voffB); PG8_STAGE(PG8_SB(0, 1), cB + hB, voffB); PG8_STAGE(PG8_SA(0, 0), cA, voffA); PG8_STAGE(PG8_SA(0, 1), cA + hA, voffA);
    if (wr == 1) PG8_BAR;
    PG8_WAIT_V(2); PG8_BAR;
    PG8_STAGE(PG8_SB(1, 0), cB + kB, voffB); PG8_STAGE(PG8_SA(1, 0), cA + kA, voffA); PG8_STAGE(PG8_SB(1, 1), cB + hB + kB, voffB);
    PG8_WAIT_V(6); PG8_BAR;
    for (;;) {
        const bool has_next = S.next(ui + 1, nxt);
        const char* nA = has_next ? g.A + (size_t)nxt.g * g.a_g + (size_t)nxt.pm * tA : cA; const char* nB = has_next ? g.B + (size_t)nxt.g * g.b_g + (size_t)nxt.pn * tB : cB;
        for (int t = 0; t < nt; t += 2) {
            const bool last = (t == nt - 2);
            const char* a1 = cA + (size_t)(t + 1) * kA;
            const char* a2 = last ? nA : cA + (size_t)(t + 2) * kA; const char* b2 = last ? nB : cB + (size_t)(t + 2) * kB;
            const char* a3 = a2 + kA; const char* b3 = b2 + kB;
            PG8_LDB(B0, 0, 0); PG8_LDB(B1, 0, 1); PG8_SCHED; PG8_LDA(At, 0, 0); PG8_STAGE(PG8_SA(1, 1), a1 + hA, voffA);
            PG8_WAIT_V(8); PG8_WAIT_L(0); PG8_BAR; PG8_MMA(0, 0, At, B0); PG8_MMA(0, 1, At, B1); PG8_BAR; PG8_SCHED;
            PG8_LDA(At, 0, 1); PG8_STAGE(PG8_SB(0, 0), b2, voffB); PG8_STAGE(PG8_SB(0, 1), b2 + hB, voffB); PG8_STAGE(PG8_SA(0, 0), a2, voffA);
            PG8_WAIT_V(8); PG8_WAIT_L(0); PG8_BAR; PG8_MMA(1, 0, At, B0); PG8_MMA(1, 1, At, B1); PG8_BAR; PG8_SCHED;
            PG8_LDB(B0, 1, 0); PG8_LDB(B1, 1, 1); PG8_SCHED; PG8_LDA(At, 1, 0); PG8_STAGE(PG8_SA(0, 1), a2 + hA, voffA);
            PG8_WAIT_V(8); PG8_WAIT_L(0); PG8_BAR; PG8_MMA(0, 0, At, B0); PG8_MMA(0, 1, At, B1); PG8_BAR; PG8_SCHED;
            PG8_LDA(At, 1, 1); PG8_STAGE(PG8_SB(1, 0), b3, voffB); PG8_STAGE(PG8_SB(1, 1), b3 + hB, voffB); PG8_STAGE(PG8_SA(1, 0), a3, voffA);
            PG8_WAIT_V(8); PG8_WAIT_L(0); PG8_BAR; PG8_MMA(1, 0, At, B0); PG8_MMA(1, 1, At, B1); PG8_BAR; PG8_SCHED;
        }
        if (wr == 0) PG8_BAR;
        E(acc, cur, wr, wc, fr, fq);
        if (!has_next) break;
#pragma unroll
        for (int a = 0; a < 2; ++a)
#pragma unroll
            for (int b = 0; b < 2; ++b)
#pragma unroll
                for (int m = 0; m < 4; ++m)
#pragma unroll
                    for (int n = 0; n < 2; ++n) acc[a][b][m][n] = (f32x4){0.f, 0.f, 0.f, 0.f};
        cur = nxt; cA = nA; cB = nB; ++ui;
        if (wr == 1) PG8_BAR;
    }
    PG8_WAIT_V(0);
    PG8_BAR;
#undef PG8_SA
#undef PG8_SB
#undef PG8_STAGE
#undef PG8_LDA
#undef PG8_LDB
#undef PG8_MMA
#undef PG8_WAIT_V
#undef PG8_WAIT_L
#undef PG8_BAR
#undef PG8_SCHED
}
}
namespace attn_body {
using bf16=__hip_bfloat16;
using bf16x8=__attribute__((ext_vector_type(8)))short;
using s16x4=__attribute__((ext_vector_type(4)))short;
using f32x16=__attribute__((ext_vector_type(16)))float;
using u32x4=__attribute__((ext_vector_type(4)))unsigned;
constexpr int BATCH=4,NHEAD=16,SEQ=8192,D=64,DM=NHEAD*D,DMK=256;
constexpr int NW=8,QBLK=32,QB=QBLK*NW,KVBLK=64,NQB=SEQ/QB;
constexpr int ATTN_PITCH=DM, ATTN_UNIT_ROWS=QB;
__device__ __forceinline__ int crow(int r,int hi){return (r&3)+8*(r>>2)+4*hi;}
#define SBAR() __builtin_amdgcn_sched_barrier(0)
__device__ __forceinline__ void cmask(f32x16&p0,f32x16&p1,int jb,int qrel,int hi){
  const float NEG=-INFINITY; int kb=64*jb+4*hi;
  #pragma unroll
  for(int r=0;r<16;++r){int kv=kb+(r&3)+8*(r>>2); if(kv>qrel)p0[r]=NEG; if(kv+32>qrel)p1[r]=NEG;}
}

constexpr int NSLOT=3, SLOTB=8192;
constexpr int LDS_K=0, LDS_V=NSLOT*SLOTB, LDS_WS=2*NSLOT*SLOTB, LDS_OST=LDS_WS+NW*64*4, LDS_BYTES=LDS_OST+NW*4096;
constexpr float C2=0.125f*1.4426950408889634f;
__device__ __forceinline__ void glds16(const void*gsrc,unsigned lds_dst){unsigned keep;
  asm volatile("s_mov_b32 %0, m0\n\ts_mov_b32 m0, %2\n\ts_nop 0\n\tglobal_load_lds_dwordx4 %1, off\n\ts_mov_b32 m0, %0":"=&s"(keep):"v"(gsrc),"s"(lds_dst):"memory");}
__device__ __forceinline__ float max3f(float a,float b,float c){float r;asm("v_max3_f32 %0, %1, %2, %3":"=v"(r):"v"(a),"v"(b),"v"(c));return r;}
__device__ __forceinline__ float max2f(float a,float b){float r;asm("v_max_f32_e32 %0, %1, %2":"=v"(r):"v"(a),"v"(b));return r;}
__device__ __forceinline__ float fadd_s(float a,float b){float r;asm("v_add_f32_e32 %0, %1, %2":"=v"(r):"v"(a),"v"(b));return r;}
__device__ __forceinline__ float fsub_s(float a,float b){float r;asm("v_sub_f32_e32 %0, %1, %2":"=v"(r):"v"(a),"v"(b));return r;}
typedef float f32x2_t __attribute__((ext_vector_type(2))); typedef __bf16 bf16x2_t __attribute__((ext_vector_type(2)));
__device__ __forceinline__ unsigned cvtpk_s(float lo,float hi){f32x2_t v={lo,hi};bf16x2_t b=__builtin_convertvector(v,bf16x2_t);return __builtin_bit_cast(unsigned,b);}
#define WAIT_BAR(N) asm volatile("s_waitcnt vmcnt(" #N ") lgkmcnt(0)\n\ts_barrier":::"memory")

__device__ __forceinline__ void qkt(f32x16&p0,f32x16&p1,const char*Kslot,const bf16x8*qr,const f32x16&negm,int r32,int hi){
  const char*kb=Kslot+hi*1024+r32*16;
  #pragma unroll
  for(int d0=0;d0<4;++d0){
    const bf16x8 b0=*reinterpret_cast<const bf16x8*>(kb+d0*2048);
    const bf16x8 b1=*reinterpret_cast<const bf16x8*>(kb+d0*2048+512);
    if(d0==0){p0=__builtin_amdgcn_mfma_f32_32x32x16_bf16(b0,qr[0],negm,0,0,0);p1=__builtin_amdgcn_mfma_f32_32x32x16_bf16(b1,qr[0],negm,0,0,0);}
    else{p0=__builtin_amdgcn_mfma_f32_32x32x16_bf16(b0,qr[d0],p0,0,0,0);p1=__builtin_amdgcn_mfma_f32_32x32x16_bf16(b1,qr[d0],p1,0,0,0);}}
}
typedef __attribute__((address_space(3))) const char* lds_cptr;
typedef short v4i16_t __attribute__((ext_vector_type(4)));
__device__ __forceinline__ void kload8(bf16x8*kf,lds_cptr kp){
  kf[0]=*(const __attribute__((address_space(3))) bf16x8*)(kp);      kf[1]=*(const __attribute__((address_space(3))) bf16x8*)(kp+512);
  kf[2]=*(const __attribute__((address_space(3))) bf16x8*)(kp+2048); kf[3]=*(const __attribute__((address_space(3))) bf16x8*)(kp+2560);
  kf[4]=*(const __attribute__((address_space(3))) bf16x8*)(kp+4096); kf[5]=*(const __attribute__((address_space(3))) bf16x8*)(kp+4608);
  kf[6]=*(const __attribute__((address_space(3))) bf16x8*)(kp+6144); kf[7]=*(const __attribute__((address_space(3))) bf16x8*)(kp+6656);
}
__device__ __forceinline__ void kload2(bf16x8*kf,lds_cptr kp,int j){ kf[2*j]=*(const __attribute__((address_space(3))) bf16x8*)(kp+j*2048); kf[2*j+1]=*(const __attribute__((address_space(3))) bf16x8*)(kp+j*2048+512); }
__device__ __forceinline__ s16x4 vtr(lds_cptr p){ return __builtin_bit_cast(s16x4,__builtin_amdgcn_ds_read_tr16_b64_v4i16((__attribute__((address_space(3))) v4i16_t*)p)); }
__device__ __forceinline__ float rowmax(const f32x16&p0,const f32x16&p1){
  float a=max3f(p0[0],p0[1],p1[0]),b=max3f(p0[2],p0[3],p1[1]);a=max3f(a,p1[2],p1[3]);
  #pragma unroll
  for(int r=4;r<16;r+=4){a=max3f(a,p0[r],p0[r+1]);b=max3f(b,p0[r+2],p0[r+3]);a=max3f(a,p1[r],p1[r+1]);b=max3f(b,p1[r+2],p1[r+3]);}
  const float m=max2f(a,b);
  auto rr=__builtin_amdgcn_permlane32_swap(__float_as_uint(m),__float_as_uint(m),false,false);
  return max2f(__uint_as_float(rr[0]),__uint_as_float(rr[1]));
}
__device__ __forceinline__ void pv(f32x16*o,int vb,bf16x8 pa0,bf16x8 pa1,bf16x8 pa2,bf16x8 pa3){
  #pragma unroll
  for(int d0=0;d0<2;++d0){s16x4 lo[4],hi[4];
    #pragma unroll
    for(int ks=0;ks<4;++ks){
      asm volatile("ds_read_b64_tr_b16 %0,%1 offset:%c2":"=&v"(lo[ks]):"v"(vb),"i"(d0*4096+ks*1024):"memory");
      asm volatile("ds_read_b64_tr_b16 %0,%1 offset:%c2":"=&v"(hi[ks]):"v"(vb),"i"(d0*4096+ks*1024+512):"memory");}
    asm volatile("s_waitcnt lgkmcnt(0)":::"memory");SBAR();
    #define PK(k) (bf16x8){lo[k][0],lo[k][1],lo[k][2],lo[k][3],hi[k][0],hi[k][1],hi[k][2],hi[k][3]}
    o[d0]=__builtin_amdgcn_mfma_f32_32x32x16_bf16(pa0,PK(0),o[d0],0,0,0);
    o[d0]=__builtin_amdgcn_mfma_f32_32x32x16_bf16(pa1,PK(1),o[d0],0,0,0);
    o[d0]=__builtin_amdgcn_mfma_f32_32x32x16_bf16(pa2,PK(2),o[d0],0,0,0);
    o[d0]=__builtin_amdgcn_mfma_f32_32x32x16_bf16(pa3,PK(3),o[d0],0,0,0);
    #undef PK
  }
}

#ifndef ATTN_STORE16
#define ATTN_STORE16(p,v) (*(u32x4*)(p)=(v))
#endif
template<int THRL> __device__ __forceinline__ void attn_unit(int b,int h,int qb,const bf16*Q,const bf16*__restrict__ K,const bf16*__restrict__ V,bf16*O,char*shm){
  const int tid=ltid(),lane=tid&63,r32=lane&31,hi=lane>>5; const int wid=__builtin_amdgcn_readfirstlane(tid>>6);
  const long rowbase=(long)b*SEQ; const int q0=qb*QB;
  const bf16*Qw=Q+(rowbase+q0+wid*QBLK)*DM+h*D;
  const bf16*Kh=K+rowbase*DMK+(h>>2)*D,*Vh=V+rowbase*DMK+(h>>2)*D;
  const unsigned lds0=(unsigned)(uintptr_t)shm;
  float*wsf=(float*)(shm+LDS_WS)+wid*64;
  const bf16*ksrc=Kh+(long)lane*DMK+wid*8;
  const bf16*vsrc=Vh+(long)(16*(wid&3)+(lane>>2))*DMK+(wid>>2)*32+(lane&3)*8;
  const unsigned kdst=lds0+LDS_K+wid*1024, vdst=lds0+LDS_V+wid*1024;
  #define DMA_K(t,slot) glds16(ksrc+(long)(t)*KVBLK*DMK,(unsigned)__builtin_amdgcn_readfirstlane(kdst+(slot)))
  #define DMA_V(t,slot) glds16(vsrc+(long)(t)*KVBLK*DMK,(unsigned)__builtin_amdgcn_readfirstlane(vdst+(slot)))
  const int vb0=(int)(lds0+LDS_V)+((lane>>4)&1)*32+(lane&3)*8+(4*hi+((lane&15)>>2))*64;
  const char*Kbase=shm+LDS_K; bf16x8 kf[8];
  const lds_cptr shm3=(lds_cptr)shm; const lds_cptr kp0=shm3+LDS_K+hi*1024+r32*16; const lds_cptr vp0=shm3+LDS_V+((lane>>4)&1)*32+(lane&3)*8+(4*hi+((lane&15)>>2))*64;
  const int NT=SEQ/KVBLK;
  DMA_K(0,0);DMA_V(0,0);DMA_K(1,SLOTB);
  bf16x8 qr[4];
  #pragma unroll
  for(int d0=0;d0<4;++d0)qr[d0]=*reinterpret_cast<const bf16x8*>(&Qw[(long)r32*DM+d0*16+hi*8]);
  float mhat=0.f,l_reg=0.f;f32x16 o[2];o[0]=f32x16{};o[1]=f32x16{};f32x16 negm=f32x16{};asm volatile("":"+v"(negm));
  const int qrel=wid*QBLK+r32;
  #define CMASK(P0,P1,t) do{}while(0)
  bool resc=false;
  #define START(P0,P1) do{ const float rm=rowmax(P0,P1); resc=false; \
    { const float dl=rm; mhat=fadd_s(mhat,dl); \
      _Pragma("unroll") for(int r=0;r<16;++r){P0[r]=fsub_s(P0[r],dl);P1[r]=fsub_s(P1[r],dl);} \
      _Pragma("unroll") for(int r=0;r<16;++r)negm[r]=-mhat; asm volatile("":"+v"(negm)); } \
    _Pragma("unroll") for(int r=0;r<16;++r)P0[r]=__builtin_amdgcn_exp2f(P0[r]); }while(0)
  #define RESC() do{ if(resc){ asm volatile("s_waitcnt lgkmcnt(0)":::"memory"); \
      _Pragma("unroll") for(int d_=0;d_<2;++d_) _Pragma("unroll") for(int r=0;r<16;++r)o[d_][r]*=wsf[crow(r,hi)]; } }while(0)
  f32x16 pA0,pA1,pB0,pB1;
  int sl_prev=0,sl_cur=0,sl_next=SLOTB;
  #define ROT() do{sl_prev=sl_cur;sl_cur=sl_next;sl_next=(sl_next==(NSLOT-1)*SLOTB)?0:sl_next+SLOTB;}while(0)
  DMA_K(2,2*SLOTB);
  WAIT_BAR(3);
  qkt(pA0,pA1,Kbase,qr,negm,r32,hi);asm volatile("s_nop 15\n\ts_nop 7":"+v"(pA0),"+v"(pA1));CMASK(pA0,pA1,0);
  START(pA0,pA1);
  _Pragma("unroll") for(int r=0;r<16;++r)pA1[r]=__builtin_amdgcn_exp2f(pA1[r]);
  WAIT_BAR(0);
  DMA_K(3,0);DMA_V(1,SLOTB);
  ROT();
  kload8(kf,kp0+sl_cur);
  WAIT_BAR(2);
  s16x4 vlo[8],vhi[8]; u32x4 pw0,pw1,pw2,pw3;
  #define PKW(P,B) cvtpk_s(P[B],P[B+1])
  #define PAF(k) __builtin_bit_cast(bf16x8,pw##k)
  #define VFR(i) (bf16x8){vlo[i][0],vlo[i][1],vlo[i][2],vlo[i][3],vhi[i][0],vhi[i][1],vhi[i][2],vhi[i][3]}
  #define PIN(x) asm volatile("":"+v"(x))
  #define MX3(a,b,c) __builtin_fmaxf(__builtin_fmaxf((a),(b)),(c))
  #define GAPA(MF,A0,A1,A2,A3,W0,W1,PW) do{ MF; sacc+=A0; sacc+=A1; sacc+=A2; sacc+=A3; PIN(sacc); W0; W1; PIN(PW); SBAR(); }while(0)
  #define EX(v) __builtin_amdgcn_exp2f(v)
  #define GAPB(MF,X,B) do{ MF; X[B]=EX(X[B]); X[B+1]=EX(X[B+1]); X[B+2]=EX(X[B+2]); X[B+3]=EX(X[B+3]); PIN(X); SBAR(); }while(0)
  #define VRD(i) do{ vlo[i]=vtr(vp_+(((i)>>2)*4096+((i)&3)*1024)); vhi[i]=vtr(vp_+(((i)>>2)*4096+((i)&3)*1024+512)); }while(0)
  #define KRD(G,j) do{ if(G){ kload2(kf,kp0+sl_next,j); SBAR(); } }while(0)
  #define STEP(C0,C1,P0,P1,t,GK,GV,GL) do{ SBAR(); \
    const lds_cptr vp_=vp0+sl_prev; \
    VRD(0); SBAR(); float sacc=(P0[0]+P0[1]); \
    GAPA(C0=__builtin_amdgcn_mfma_f32_32x32x16_bf16(kf[0],qr[0],negm,0,0,0), P0[2],P0[3],P0[4],P0[5],     pw0[0]=PKW(P0,0), pw0[1]=PKW(P0,2), pw0); \
    VRD(4); SBAR(); GAPA(C1=__builtin_amdgcn_mfma_f32_32x32x16_bf16(kf[1],qr[0],negm,0,0,0), P0[6],P0[7],P0[8],P0[9],     pw0[2]=PKW(P0,4), pw0[3]=PKW(P0,6), pw0); \
    VRD(1); SBAR(); GAPA(C0=__builtin_amdgcn_mfma_f32_32x32x16_bf16(kf[2],qr[1],C0,0,0,0),   P0[10],P0[11],P0[12],P0[13], pw1[0]=PKW(P0,8), pw1[1]=PKW(P0,10), pw1); \
    VRD(5); SBAR(); GAPA(C1=__builtin_amdgcn_mfma_f32_32x32x16_bf16(kf[3],qr[1],C1,0,0,0),   P0[14],P0[15],P1[0],P1[1],   pw1[2]=PKW(P0,12),pw1[3]=PKW(P0,14), pw1); \
    VRD(2); SBAR(); GAPA(C0=__builtin_amdgcn_mfma_f32_32x32x16_bf16(kf[4],qr[2],C0,0,0,0),   P1[2],P1[3],P1[4],P1[5],     pw2[0]=PKW(P1,0), pw2[1]=PKW(P1,2), pw2); \
    VRD(6); SBAR(); GAPA(C1=__builtin_amdgcn_mfma_f32_32x32x16_bf16(kf[5],qr[2],C1,0,0,0),   P1[6],P1[7],P1[8],P1[9],     pw2[2]=PKW(P1,4), pw2[3]=PKW(P1,6), pw2); \
    VRD(3); SBAR(); GAPA(C0=__builtin_amdgcn_mfma_f32_32x32x16_bf16(kf[6],qr[3],C0,0,0,0),   P1[10],P1[11],P1[12],P1[13], pw3[0]=PKW(P1,8), pw3[1]=PKW(P1,10), pw3); \
    VRD(7); SBAR(); GAPA(C1=__builtin_amdgcn_mfma_f32_32x32x16_bf16(kf[7],qr[3],C1,0,0,0),   P1[14],P1[15],0.f,0.f,       pw3[2]=PKW(P1,12),pw3[3]=PKW(P1,14), pw3); \
    l_reg+=sacc; \
    if(GK){DMA_K((t)+3,sl_cur);} if(GV){DMA_V((t)+1,sl_next);} \
    CMASK(C0,C1,t); \
    { float a=MX3(C0[0],C0[1],C1[0]),b=MX3(C0[2],C0[3],C1[1]); a=MX3(a,C1[2],C1[3]); \
      _Pragma("unroll") for(int r=4;r<16;r+=4){a=MX3(a,C0[r],C0[r+1]);b=MX3(b,C0[r+2],C0[r+3]);a=MX3(a,C1[r],C1[r+1]);b=MX3(b,C1[r+2],C1[r+3]);} \
      float rm=__builtin_fmaxf(a,b); { auto rr=__builtin_amdgcn_permlane32_swap(__float_as_uint(rm),__float_as_uint(rm),false,false); rm=__builtin_fmaxf(__uint_as_float(rr[0]),__uint_as_float(rr[1])); } \
      resc=false; \
      if(__builtin_expect(__any(rm>(float)THRL),0)){ const float dl=__builtin_fmaxf(rm,0.f); mhat+=dl; \
        _Pragma("unroll") for(int r=0;r<16;++r){C0[r]-=dl;C1[r]-=dl;} \
        _Pragma("unroll") for(int r=0;r<16;++r)negm[r]=-mhat; asm volatile("":"+v"(negm)); \
        const float f=__builtin_amdgcn_exp2f(-dl); l_reg*=f; if(hi==0)wsf[r32]=f; resc=true; } } \
    SBAR(); \
    GAPB(o[0]=__builtin_amdgcn_mfma_f32_32x32x16_bf16(PAF(0),VFR(0),o[0],0,0,0), C0,0); \
    GAPB(o[1]=__builtin_amdgcn_mfma_f32_32x32x16_bf16(PAF(0),VFR(4),o[1],0,0,0), C0,4); \
    KRD(GL,0); GAPB(o[0]=__builtin_amdgcn_mfma_f32_32x32x16_bf16(PAF(1),VFR(1),o[0],0,0,0), C0,8); \
    KRD(GL,1); GAPB(o[1]=__builtin_amdgcn_mfma_f32_32x32x16_bf16(PAF(1),VFR(5),o[1],0,0,0), C0,12); \
    KRD(GL,2); GAPB(o[0]=__builtin_amdgcn_mfma_f32_32x32x16_bf16(PAF(2),VFR(2),o[0],0,0,0), C1,0); \
    KRD(GL,3); GAPB(o[1]=__builtin_amdgcn_mfma_f32_32x32x16_bf16(PAF(2),VFR(6),o[1],0,0,0), C1,4); \
    GAPB(o[0]=__builtin_amdgcn_mfma_f32_32x32x16_bf16(PAF(3),VFR(3),o[0],0,0,0), C1,8); \
    GAPB(o[1]=__builtin_amdgcn_mfma_f32_32x32x16_bf16(PAF(3),VFR(7),o[1],0,0,0), C1,12); \
    }while(0)
  int t=1;
  #undef CMASK
  #define CMASK(P0,P1,t) do{}while(0)
  for(;t+5<NT;t+=2){
    STEP(pB0,pB1,pA0,pA1,t,true,true,true);     WAIT_BAR(2); RESC(); ROT();
    STEP(pA0,pA1,pB0,pB1,t+1,true,true,true);   WAIT_BAR(2); RESC(); ROT();
  }
  #undef CMASK
  #define CMASK(P0,P1,t) do{}while(0)
  #define ENDW(tt) do{ if((tt)+3<NT){WAIT_BAR(2);} else if((tt)+2<NT){WAIT_BAR(1);} else {WAIT_BAR(0);} }while(0)
  for(;t+1<NT;t+=2){
    STEP(pB0,pB1,pA0,pA1,t,(t+3<NT),(t+1<NT),(t+1<NT));       ENDW(t);   RESC(); ROT();
    STEP(pA0,pA1,pB0,pB1,t+1,(t+4<NT),(t+2<NT),(t+2<NT));     ENDW(t+1); RESC(); ROT();
  }
  STEP(pB0,pB1,pA0,pA1,NT-1,false,false,false); RESC();
  { float sacc=pB0[0]+pB0[1]; _Pragma("unroll") for(int r=2;r<16;++r)sacc+=pB0[r]; _Pragma("unroll") for(int r=0;r<16;++r)sacc+=pB1[r]; l_reg+=sacc;
    pw0=(u32x4){PKW(pB0,0),PKW(pB0,2),PKW(pB0,4),PKW(pB0,6)};pw1=(u32x4){PKW(pB0,8),PKW(pB0,10),PKW(pB0,12),PKW(pB0,14)};pw2=(u32x4){PKW(pB1,0),PKW(pB1,2),PKW(pB1,4),PKW(pB1,6)};pw3=(u32x4){PKW(pB1,8),PKW(pB1,10),PKW(pB1,12),PKW(pB1,14)};
    SBAR(); pv(o,vb0+sl_cur,PAF(0),PAF(1),PAF(2),PAF(3)); }
  #undef PKW
  #undef PAF
  #undef VFR
  #undef PIN
  #undef MX3
  #undef GAPA
  #undef GAPB
  #undef EX
  #undef VRD
  #undef KRD
  #undef STEP
  #undef ENDW
  {auto rr=__builtin_amdgcn_permlane32_swap(__float_as_uint(l_reg),__float_as_uint(l_reg),false,false);l_reg=__uint_as_float(rr[0])+__uint_as_float(rr[1]);}
  if(hi==0)wsf[32+r32]=l_reg;asm volatile("s_waitcnt lgkmcnt(0)":::"memory");
  float rli[16];
  #pragma unroll
  for(int r=0;r<16;++r)rli[r]=__builtin_amdgcn_rcpf(wsf[32+crow(r,hi)]);
  bf16*Ow=O+(rowbase+q0+wid*QBLK)*DM+h*D;
  { bf16*stg=(bf16*)(shm+LDS_OST)+wid*2048;
    #pragma unroll
    for(int r=0;r<16;++r){const int orow=crow(r,hi);
      #pragma unroll
      for(int d0=0;d0<2;++d0)stg[orow*64+d0*32+r32]=__float2bfloat16(o[d0][r]*rli[r]);}
    asm volatile("s_waitcnt lgkmcnt(0)":::"memory");
    #pragma unroll
    for(int i=0;i<4;++i){const int row=i*8+(lane>>3),ch=lane&7; const u32x4 v=*(const u32x4*)(stg+row*64+ch*8); ATTN_STORE16(Ow+(long)row*DM+ch*8,v);} }
  asm volatile("s_waitcnt lgkmcnt(0)\n\ts_barrier":::"memory");
  #undef DMA_K
  #undef DMA_V
  #undef CMASK
  #undef START
  #undef RESC
  #undef ROT
}
constexpr int ATTN_LDS_BYTES=LDS_BYTES;
struct AttnTensors { const bf16* Q; const bf16* K; const bf16* V; bf16* O; };
struct AttnUnit { int bh; int qb; };
struct StaticOrder {
  int vcu, G, bid;
  __device__ __forceinline__ explicit StaticOrder(int grid,int block):vcu((grid%8==0)?(block%8)*(grid/8)+block/8:block),G(grid),bid(block){}
  __device__ __forceinline__ bool next(int i,AttnUnit&u)const{
    if(G==256){ if(i>=8)return false; const int xcd=vcu>>5,c=vcu&31,kvg=xcd+8*(i>>2);
      u.bh=(kvg>>2)*16+(kvg&3)*4+(c>>3); u.qb=(c&7)*4+(i&3); return true; }
    const int id=i*G+bid; if(id>=BATCH*NHEAD*NQB)return false; u.bh=id/NQB; u.qb=id%NQB; return true; }
  __device__ __forceinline__ void a_ready(const AttnUnit&)const{}
  __device__ __forceinline__ void done(const AttnUnit&)const{}
};
template<class Sched,int THRL=8> __device__ __forceinline__ void attn_phase(char*lds,const AttnTensors&T,const Sched&S){
  AttnUnit u;
  for(int i=0;S.next(i,u);++i){ S.a_ready(u); attn_unit<THRL>(u.bh/NHEAD,u.bh%NHEAD,u.qb,T.Q,T.K,T.V,T.O,lds); S.done(u); }
}
#undef SBAR
#undef WAIT_BAR
}

constexpr size_t MiB = 1u << 20;
constexpr size_t WS_MODP = 1 * MiB;
constexpr size_t WS_MOD  = 4 * MiB;
constexpr size_t WS_A2   = 5 * MiB;
constexpr size_t WS_LP   = 7 * MiB + 512 * 1024;
constexpr size_t WS_BBAR = 10 * MiB;
constexpr size_t WS_KTAB = 11 * MiB;
constexpr size_t WS_SS   = 15 * MiB;
constexpr size_t WS_BIAS = 1 * MiB;
constexpr size_t R_H2 = 168 * MiB + 192 * MiB;
constexpr size_t WS_ROPE = 2 * MiB;
constexpr size_t WS_BAR  = 4 * MiB + 384 * 1024;
constexpr size_t WS_W    = 16 * MiB;
constexpr size_t WS_H    = 104 * MiB;
constexpr size_t WS_R    = 168 * MiB;
constexpr size_t WS_END  = 512 * MiB;
constexpr size_t WO_UP(int i) { return (size_t)i * 8650752; }
constexpr size_t WO_DN(int i) { return (size_t)i * 8650752 + 5767168; }
constexpr size_t WO_QKV(int j) { return 34603008 + (size_t)j * 2621440; }
constexpr size_t WO_WO(int j) { return 34603008 + (size_t)j * 2621440 + 1572864; }
constexpr size_t WO_HIN = 39845888, WO_HOUT = 39845888 + 3145728, WO_GLU = 44040192;
constexpr size_t R_QKV = WS_R, R_QN = WS_R + 96 * MiB, R_KN = WS_R + 160 * MiB, R_VC = WS_R + 176 * MiB;
constexpr size_t R_G = WS_R, R_HALO = WS_R + 176 * MiB;
constexpr size_t R_UPRE = WS_R, R_X1 = WS_R + 192 * MiB, R_X2 = WS_R + 256 * MiB;
constexpr size_t R_Z1S = WS_R + 192 * MiB, R_KFS = WS_R + 224 * MiB, R_Z2 = WS_H, R_Z2T = WS_R;
constexpr size_t R_BT1 = WS_R, R_CM = WS_R + 48 * MiB, R_YI = WS_R + 64 * MiB, R_S = WS_R + 128 * MiB, R_XC = WS_R + 192 * MiB;

constexpr int RING_BYTES = 131072, MISC_OFF = RING_BYTES, LDS_BYTES = 147456;

struct Args { const float* in[35]; float* out; unsigned char* ws; int ph_lo, ph_hi; unsigned char prog[96][4]; };
enum Kind { K_PRO = 0, K_MODRED, K_NORMMOD, K_GEMM_QKV, K_QKN, K_ATT, K_GEMM_WO, K_GEMM_UP, K_FFNCONV, K_GEMM_DN, K_GEMM_HIN, K_HCT, K_HFFT, K_HTR, K_GEMM_HOUT,
            K_S5PREP, K_GEMM_S1, K_S5SCAN, K_GEMM_S2, K_GEMM_GLU, K_FINAL };

struct Ctx { LAS unsigned char* lds; int tid, lane, wave, G, vcu, gw, NGW, bid; };

__device__ __forceinline__ void transpose_item(const float* W, int K, int N, bf16_t* WT, int mode, LAS float* scr, int item, int lane) {
    const int nblk = N / 32, kb = item / nblk, nb = item % nblk, k0 = 64 * kb, n0 = 32 * nb;
    float tv[32];
#pragma unroll
    for (int i = 0; i < 32; ++i) tv[i] = W[(size_t)(k0 + 2 * i + (lane >> 5)) * N + n0 + (lane & 31)];
#pragma unroll
    for (int i = 0; i < 32; ++i) scr[(2 * i + (lane >> 5)) * 33 + (lane & 31)] = tv[i];
    asm volatile("s_waitcnt lgkmcnt(0)" ::: "memory");
    int r0 = n0;
    if (mode == 1) { const int half = n0 >> 10, c = n0 & 1023; r0 = 256 * (c >> 7) + 128 * half + (c & 127); }
    if (mode == 2) { const int half = n0 / DFF, c = n0 - half * DFF; r0 = 256 * (c >> 7) + 128 * half + (c & 127); }
    const int c = lane & 7;
#pragma unroll
    for (int j = 0; j < 4; ++j) { const int n = (lane >> 3) + 8 * j; const LAS float* s = scr + (8 * c) * 33 + n;
        u32x4 o; o.x = pk2(s[0 * 33], s[1 * 33]); o.y = pk2(s[2 * 33], s[3 * 33]); o.z = pk2(s[4 * 33], s[5 * 33]); o.w = pk2(s[6 * 33], s[7 * 33]);
        *(u32x4*)(WT + (size_t)(r0 + n) * K + k0 + 8 * c) = o; }
    asm volatile("s_waitcnt lgkmcnt(0)" ::: "memory");
}

__device__ __forceinline__ void phase_prologue(const Ctx& F, const Args& a) {
    bf16_t* Wb = (bf16_t*)(a.ws + WS_W);
    LAS float* scr = (LAS float*)(F.lds + F.wave * 16384);
    for (int it = F.gw; it < 22528; it += F.NGW) {
        int r = it; const float* src; int K, N, mode = 0; size_t dsto;
        if (r < 4 * 4224) { const int i = r / 4224; r -= i * 4224;
            if (r < 2816) { src = a.in[31] + (size_t)i * 1024 * 5632; K = 1024; N = 5632; dsto = WO_UP(i); mode = 2; }
            else { r -= 2816; src = a.in[34] + (size_t)i * 2816 * 1024; K = 2816; N = 1024; dsto = WO_DN(i); } }
        else { r -= 4 * 4224;
            if (r < 2 * 1280) { const int j = r / 1280; r -= j * 1280;
                if (r < 768) { src = a.in[7] + (size_t)j * 1024 * 1536; K = 1024; N = 1536; dsto = WO_QKV(j); }
                else { r -= 768; src = a.in[8] + (size_t)j * 1024 * 1024; K = 1024; N = 1024; dsto = WO_WO(j); } }
            else { r -= 2 * 1280;
                if (r < 1536) { src = a.in[11]; K = 1024; N = 3072; dsto = WO_HIN; }
                else if (r < 2048) { r -= 1536; src = a.in[21]; K = 1024; N = 1024; dsto = WO_HOUT; }
                else { r -= 2048; src = a.in[30]; K = 1024; N = 2048; dsto = WO_GLU; mode = 1; } } }
        transpose_item(src, K, N, Wb + dsto, mode, scr, r, F.lane);
    }
    { f32x4* SS = (f32x4*)(a.ws + WS_SS); const float one = (1.0f - EPS) * (float)DM;
      for (int i = F.gw * 64 + F.lane; i < 8 * TOK / 4; i += F.NGW * 64) SS[i] = (i < TOK / 4) ? (f32x4){one, one, one, one} : (f32x4){0.f, 0.f, 0.f, 0.f}; }
    {
        const float* c = a.in[1]; const float* aw = a.in[2]; float* modp = (float*)(a.ws + WS_MODP);
        for (int it = F.gw; it < 768; it += F.NGW) {
            const int kc = it & 7, nb = (it >> 3) % 24, i = it / 192;
            f32x4 acc[4]; for (int b = 0; b < 4; ++b) acc[b] = (f32x4){0.f, 0.f, 0.f, 0.f};
            const float* wp = aw + ((size_t)i * 1024 + kc * 128) * 6144 + nb * 256 + F.lane * 4;
#pragma unroll 1
            for (int k0 = 0; k0 < 128; k0 += 16) { f32x4 wv[16];
#pragma unroll
                for (int k = 0; k < 16; ++k) wv[k] = *(const f32x4*)(wp + (size_t)(k0 + k) * 6144);
#pragma unroll
                for (int k = 0; k < 16; ++k)
#pragma unroll
                    for (int b = 0; b < 4; ++b) { const float cv = c[b * 1024 + kc * 128 + k0 + k]; const float ca = cv * sigmoidf_(cv); acc[b] = acc[b] + wv[k] * ca; } }
            { float* modo = (float*)(a.ws + WS_MOD); const f32x4 bia = (kc == 0) ? *(const f32x4*)(a.in[3] + (size_t)i * 6144 + nb * 256 + F.lane * 4) : (f32x4){0.f, 0.f, 0.f, 0.f};
#pragma unroll
              for (int b = 0; b < 4; ++b) { float* mp = modo + ((size_t)i * 4 + b) * 6144 + nb * 256 + F.lane * 4;
#pragma unroll
                  for (int e = 0; e < 4; ++e) atomicAdd(mp + e, acc[b][e] + bia[e]); } }
        }
    }
    {
        const float *w1 = a.in[14], *b1 = a.in[15], *w2 = a.in[16], *b2 = a.in[17], *fq = a.in[19]; float* A2 = (float*)(a.ws + WS_A2);
        const int j = F.lane; const float fj = fq[j], b1j = b1[j], b2j = b2[j];
        for (int it = F.gw; it < SEQ / 4; it += F.NGW) {
            const int t0 = it * 4;
            for (int tt = 0; tt < 4; ++tt) {
                const int t = t0 + tt;
                const float tl = (float)t * (1.0f / (float)(SEQ - 1));
                const float w = 6.283185307179586f * (float)t / (float)SEQ;
                float s = tl * w1[j] + b1j;
#pragma unroll
                for (int k = 0; k < 16; ++k) { const float f = 1e-4f + (float)k * ((15.0f - 1e-4f) / 15.0f); const float ang = w * f;
                    s += cosf(ang) * w1[(1 + k) * 64 + j]; s += -sinf(ang) * w1[(17 + k) * 64 + j]; }
                const float a1 = sinf(fj * s);
                float s2 = b2j;
                for (int i = 0; i < 64; ++i) s2 += bperm(a1, i) * w2[i * 64 + j];
                scr[j * 5 + tt] = sinf(fj * s2);
            }
            asm volatile("s_waitcnt lgkmcnt(0)" ::: "memory");
#pragma unroll
            for (int r = 0; r < 4; ++r) { const int idx = r * 64 + F.lane, jj = idx >> 2, tt = idx & 3; A2[(size_t)jj * (SEQ + 64) + t0 + tt] = scr[jj * 5 + tt]; }
            asm volatile("s_waitcnt lgkmcnt(0)" ::: "memory");
        }
    }
    {
        const float *Are = a.in[22], *Aim = a.in[23], *ldt = a.in[24], *Bre = a.in[25], *Bim = a.in[26];
        f32x2* LP = (f32x2*)(a.ws + WS_LP); f32x2* BB = (f32x2*)(a.ws + WS_BBAR);
        for (int it = F.gw; it < 128; it += F.NGW) {
            const int g = it >> 1, dir = it & 1, p = F.lane;
            const float lre = fminf(Are[(dir * 64 + g) * 64 + p], -1e-4f), lim = Aim[(dir * 64 + g) * 64 + p]; const float dt = expf(ldt[dir * 64 + g]);
            for (int n = 0; n <= 32; ++n) { const float mg = expf((float)n * lre * dt), an = (float)n * lim * dt; LP[((size_t)(g * 2 + dir) * 33 + n) * 64 + p] = (f32x2){mg * cosf(an), mg * sinf(an)}; }
            const float mg = expf(lre * dt), an = lim * dt; const float nr = mg * cosf(an) - 1.0f, ni = mg * sinf(an);
            const float den = lre * lre + lim * lim; const float cr = (nr * lre + ni * lim) / den, ci = (ni * lre - nr * lim) / den;
            for (int h = 0; h < 16; ++h) { const size_t bi = ((size_t)(dir * 64 + g) * 64 + p) * 16 + h; const float br = Bre[bi], bm = Bim[bi];
                BB[((size_t)(g * 2 + dir) * 64 + p) * 16 + h] = (f32x2){cr * br - ci * bm, cr * bm + ci * br}; }
        }
    }
}

__device__ __forceinline__ void phase_modred(const Ctx& F, const Args& a) {
    const float *Cre = a.in[27], *Cim = a.in[28]; const f32x2* LP = (const f32x2*)(a.ws + WS_LP); const f32x2* BB = (const f32x2*)(a.ws + WS_BBAR); float* KT = (float*)(a.ws + WS_KTAB);
    for (int it = F.gw; it < 64 * 2 * 32; it += F.NGW) {
        const int tau = it & 31, dir = (it >> 5) & 1, g = it >> 6; const int gd = g * 2 + dir;
        const int ho = F.lane >> 2, hi0 = 4 * (F.lane & 3); float acc[4] = {0.f, 0.f, 0.f, 0.f};
#pragma unroll 1
        for (int p0 = 0; p0 < 64; p0 += 8) {
            f32x2 lv[8]; float crv[8], cmv[8]; f32x4 bv[8][2];
#pragma unroll
            for (int k = 0; k < 8; ++k) { const int p = p0 + k; lv[k] = LP[((size_t)gd * 33 + tau) * 64 + p]; const size_t ci = ((size_t)(dir * 64 + g) * 16 + ho) * 64 + p; crv[k] = Cre[ci]; cmv[k] = Cim[ci];
                const f32x4* bp = (const f32x4*)(BB + ((size_t)gd * 64 + p) * 16 + hi0); bv[k][0] = bp[0]; bv[k][1] = bp[1]; }
#pragma unroll
            for (int k = 0; k < 8; ++k) { const float er = crv[k] * lv[k].x - cmv[k] * lv[k].y, ei = crv[k] * lv[k].y + cmv[k] * lv[k].x;
                acc[0] += er * bv[k][0].x - ei * bv[k][0].y; acc[1] += er * bv[k][0].z - ei * bv[k][0].w; acc[2] += er * bv[k][1].x - ei * bv[k][1].y; acc[3] += er * bv[k][1].z - ei * bv[k][1].w; }
        }
        *(f32x4*)(KT + (((size_t)gd * 32 + tau) * 16 + ho) * 16 + hi0) = (f32x4){acc[0], acc[1], acc[2], acc[3]};
    }
}

__device__ __forceinline__ void phase_normmod(const Ctx& F, const Args& a, int layer, int which) {
    const bool first = (layer == 0 && which == 0);
    const float* src = first ? a.in[0] : a.out; float* X = a.out; bf16_t* H = (bf16_t*)(a.ws + WS_H);
    const float* gn = (which ? a.in[5] : a.in[4]) + layer * 1024; const float* mod = (const float*)(a.ws + WS_MOD) + (size_t)layer * 4 * 6144 + which * 3072;
    const int rows_per = TOK / F.NGW;
    const int r0 = F.gw * rows_per, b = r0 / SEQ;
    f32x4 cs[4], sh[4];
#pragma unroll
    for (int j = 0; j < 4; ++j) { const int c = (F.lane + 64 * j) * 4; const f32x4 g = *(const f32x4*)(gn + c), sc = *(const f32x4*)(mod + (size_t)b * 6144 + 1024 + c); sh[j] = *(const f32x4*)(mod + (size_t)b * 6144 + c); cs[j] = g * (sc + 1.0f); }
#pragma unroll 1
    for (int r = r0; r < r0 + rows_per; r += 4) {
        f32x4 v[4][4];
#pragma unroll
        for (int q = 0; q < 4; ++q) { const f32x4* xr = (const f32x4*)(src + (size_t)(r + q) * DM) + F.lane;
#pragma unroll
            for (int j = 0; j < 4; ++j) v[q][j] = xr[64 * j]; }
#pragma unroll
        for (int q = 0; q < 4; ++q) { float s = 0.f;
#pragma unroll
            for (int j = 0; j < 4; ++j) s += (v[q][j].x * v[q][j].x + v[q][j].y * v[q][j].y) + (v[q][j].z * v[q][j].z + v[q][j].w * v[q][j].w);
            const float rstd = 1.0f / sqrtf(wave_sum(s, F.lane) * (1.0f / DM) + EPS);
            u32x2* o8 = (u32x2*)(H + (size_t)(r + q) * DM) + F.lane;
#pragma unroll
            for (int j = 0; j < 4; ++j) { const f32x4 y = v[q][j] * rstd * cs[j] + sh[j]; o8[64 * j] = (u32x2){pk2(y.x, y.y), pk2(y.z, y.w)}; }
            }
    }
}
__device__ __forceinline__ void phase_bias(const Ctx& F, const Args& a) {
    const bf16_t* Wb = (const bf16_t*)(a.ws + WS_W); const float* mod = (const float*)(a.ws + WS_MOD); float* bias = (float*)(a.ws + WS_BIAS);
    const int per = (pg8::NBIAS + F.NGW - 1) / F.NGW; const int r0 = F.gw * per, r1 = (r0 + per < pg8::NBIAS) ? r0 + per : pg8::NBIAS;
    {
        f32x2* rope = (f32x2*)(a.ws + WS_ROPE); const int pi = F.lane & 31; const float inv = 1.0f / powf(10000.0f, (float)(pi & 15) / 16.0f);
        for (int it = F.gw; it < SEQ / 2; it += F.NGW) { const int t = it * 2 + (F.lane >> 5); const float pos = (pi < 16) ? (float)(t >> 6) : (float)(t & 63); const float ang = pos * inv;
            rope[(size_t)t * 32 + pi] = (f32x2){cosf(ang), sinf(ang)}; }
    }
    int cur = -1; f32x4 sh[4][4];
    auto rowptr = [&](int row, int& cons, int& layer, int& which) -> const bf16_t* {
        if (row < 22528) { layer = row / 5632; which = 1; cons = layer; return Wb + WO_UP(layer) + (size_t)(row - layer * 5632) * 1024; }
        if (row < 25600) { layer = 1; which = 0; cons = 4; return Wb + WO_HIN + (size_t)(row - 22528) * 1024; }
        layer = 3; which = 0; cons = 5; return Wb + WO_QKV(1) + (size_t)(row - 25600) * 1024; };
#pragma unroll 1
    for (int rb = r0; rb < r1; rb += 4) {
        u32x4 wv[4][2];
#pragma unroll
        for (int k = 0; k < 4; ++k) { const int row = (rb + k < r1) ? rb + k : r1 - 1; int c_, l_, w_; const bf16_t* wrow = rowptr(row, c_, l_, w_); wv[k][0] = *(const u32x4*)(wrow + F.lane * 16); wv[k][1] = *(const u32x4*)(wrow + F.lane * 16 + 8); }
#pragma unroll
        for (int k = 0; k < 4; ++k) { const int row = rb + k; if (row >= r1) break;
            int cons, layer, which; (void)rowptr(row, cons, layer, which);
            if (cons != cur) { cur = cons;
#pragma unroll
                for (int b = 0; b < 4; ++b)
#pragma unroll
                    for (int q = 0; q < 4; ++q) sh[b][q] = *(const f32x4*)(mod + ((size_t)layer * 4 + b) * 6144 + which * 3072 + F.lane * 16 + 4 * q); }
            float wf[16];
#pragma unroll
            for (int e = 0; e < 4; ++e) { wf[2 * e] = bflo(wv[k][0][e]); wf[2 * e + 1] = bfhi(wv[k][0][e]); wf[8 + 2 * e] = bflo(wv[k][1][e]); wf[9 + 2 * e] = bfhi(wv[k][1][e]); }
#pragma unroll
            for (int b = 0; b < 4; ++b) { float d = 0.f;
#pragma unroll
                for (int q = 0; q < 4; ++q) d += (sh[b][q].x * wf[4 * q] + sh[b][q].y * wf[4 * q + 1]) + (sh[b][q].z * wf[4 * q + 2] + sh[b][q].w * wf[4 * q + 3]);
                d = wave_sum(d, F.lane); if (F.lane == 0) bias[(size_t)b * pg8::NBIAS + row] = d; }
        }
    }
}
__device__ __forceinline__ void phase_final(const Ctx& F, const Args& a) {
    float* X = a.out; const float* gn = a.in[6];
    f32x4 g[4];
#pragma unroll
    for (int j = 0; j < 4; ++j) g[j] = *(const f32x4*)(gn + (F.lane + 64 * j) * 4);
    const int rows_per = TOK / F.NGW; const int r0 = F.gw * rows_per;
#pragma unroll 1
    for (int r = r0; r < r0 + rows_per; r += 4) {
        f32x4 v[4][4];
#pragma unroll
        for (int q = 0; q < 4; ++q) { const f32x4* xr = (const f32x4*)(X + (size_t)(r + q) * DM) + F.lane;
#pragma unroll
            for (int j = 0; j < 4; ++j) v[q][j] = xr[64 * j]; }
#pragma unroll
        for (int q = 0; q < 4; ++q) { float s = 0.f;
#pragma unroll
            for (int j = 0; j < 4; ++j) s += (v[q][j].x * v[q][j].x + v[q][j].y * v[q][j].y) + (v[q][j].z * v[q][j].z + v[q][j].w * v[q][j].w);
            const float rstd = 1.0f / sqrtf(wave_sum(s, F.lane) * (1.0f / DM) + EPS);
            f32x4* xo = (f32x4*)(X + (size_t)(r + q) * DM) + F.lane;
#pragma unroll
            for (int j = 0; j < 4; ++j) xo[64 * j] = v[q][j] * rstd * g[j]; }
    }
}

__device__ __forceinline__ void phase_qknorm(const Ctx& F, const Args& a, int j) {
    const bf16_t* QKV = (const bf16_t*)(a.ws + R_QKV); bf16_t* Qn = (bf16_t*)(a.ws + R_QN); bf16_t* Kn = (bf16_t*)(a.ws + R_KN); bf16_t* Vc = (bf16_t*)(a.ws + R_VC);
    const float* qg = a.in[9] + j * 64; const float* kg = a.in[10] + j * 64;
    const int sub = F.lane & 15, e0 = sub * 4, hsel = F.lane >> 4;
    const f32x4 gq = *(const f32x4*)(qg + e0), gk = *(const f32x4*)(kg + e0);
    const int i0 = 2 * sub, i1 = 2 * sub + 1;
    const float inv0 = 1.0f / powf(10000.0f, (float)(i0 & 15) / 16.0f), inv1 = 1.0f / powf(10000.0f, (float)(i1 & 15) / 16.0f);
    const float C2 = 0.125f * 1.4426950408889634f;
    const int rows_per = TOK / F.NGW; const int rbeg = F.gw * rows_per;
#pragma unroll 1
    for (int rb = rbeg; rb < rbeg + rows_per; rb += 4) {
        u32x2 wq[4][5], wv[4];
#pragma unroll
        for (int q = 0; q < 4; ++q) { const bf16_t* src = QKV + (size_t)(rb + q) * NQKV;
#pragma unroll
            for (int it = 0; it < 5; ++it) wq[q][it] = *(const u32x2*)(src + (it * 4 + hsel) * 64 + e0);
            wv[q] = *(const u32x2*)(src + 1280 + F.lane * 4); }
#pragma unroll
        for (int q = 0; q < 4; ++q) {
            const int row = rb + q; const int t = row & (SEQ - 1); const float pos = (i0 < 16) ? (float)(t >> 6) : (float)(t & 63);
            const float a0 = pos * inv0, a1 = pos * inv1; const float c0 = cosf(a0), s0 = sinf(a0), c1 = cosf(a1), s1 = sinf(a1);
#pragma unroll
            for (int it = 0; it < 5; ++it) {
                const int head = it * 4 + hsel; const u32x2 w = wq[q][it];
                float v0 = bflo(w.x), v1 = bfhi(w.x), v2 = bflo(w.y), v3 = bfhi(w.y);
                float ss = v0 * v0 + v1 * v1 + v2 * v2 + v3 * v3;
                ss += bperm(ss, F.lane ^ 1); ss += bperm(ss, F.lane ^ 2); ss += bperm(ss, F.lane ^ 4); ss += bperm(ss, F.lane ^ 8);
                const float rstd = 1.0f / sqrtf(ss * (1.0f / 64.0f) + EPS);
                const f32x4 gg = (it < 4) ? gq : gk;
                v0 *= rstd * gg.x; v1 *= rstd * gg.y; v2 *= rstd * gg.z; v3 *= rstd * gg.w;
                float o0 = v0 * c0 - v1 * s0, o1 = v0 * s0 + v1 * c0, o2 = v2 * c1 - v3 * s1, o3 = v2 * s1 + v3 * c1;
                if (it < 4) { o0 *= C2; o1 *= C2; o2 *= C2; o3 *= C2; *(u32x2*)(Qn + (size_t)row * 1024 + head * 64 + e0) = (u32x2){pk2(o0, o1), pk2(o2, o3)}; }
                else *(u32x2*)(Kn + (size_t)row * 256 + (head - 16) * 64 + e0) = (u32x2){pk2(o0, o1), pk2(o2, o3)};
            }
            *(u32x2*)(Vc + (size_t)row * 256 + F.lane * 4) = wv[q];
        }
    }
}

__device__ __forceinline__ void phase_ffnfix(const Ctx& F, const Args& a, int layer) {
    bf16_t* Gb = (bf16_t*)(a.ws + R_G); const float* halo = (const float*)(a.ws + R_HALO);
    const float* cw = a.in[32] + (size_t)layer * 3 * DFF; const float* cb = a.in[33] + (size_t)layer * DFF;
    for (int it = F.gw; it < 128 * 2 * 11; it += F.NGW) {
        const int seg = it % 11, lastrow = (it / 11) & 1, pm = it / 22; const int c = seg * 256 + F.lane * 4;
        const float* hp = halo + (size_t)pm * 6 * DFF + c;
        f32x4 pv, cv, nv, vv;
        if (!lastrow) { pv = (pm % 32 == 0) ? (f32x4){0.f, 0.f, 0.f, 0.f} : *(const f32x4*)(hp - 6 * DFF + 3 * DFF); cv = *(const f32x4*)hp; nv = *(const f32x4*)(hp + DFF); vv = *(const f32x4*)(hp + 4 * DFF); }
        else { pv = *(const f32x4*)(hp + 2 * DFF); cv = *(const f32x4*)(hp + 3 * DFF); nv = (pm % 32 == 31) ? (f32x4){0.f, 0.f, 0.f, 0.f} : *(const f32x4*)(hp + 6 * DFF); vv = *(const f32x4*)(hp + 5 * DFF); }
        const f32x4 w0 = *(const f32x4*)(cw + c), w1 = *(const f32x4*)(cw + DFF + c), w2 = *(const f32x4*)(cw + 2 * DFF + c), bb = *(const f32x4*)(cb + c);
        const f32x4 gt = pv * w0 + cv * w1 + nv * w2 + bb; float o[4];
#pragma unroll
        for (int e = 0; e < 4; ++e) o[e] = gt[e] * sigmoidf_(gt[e]) * vv[e];
        *(u32x2*)(Gb + (size_t)(pm * 256 + (lastrow ? 255 : 0)) * DFF + c) = (u32x2){pk2(o[0], o[1]), pk2(o[2], o[3])};
    }
}

__device__ __forceinline__ void phase_hyconvT(const Ctx& F, const Args& a) {
    const bf16_t* Up = (const bf16_t*)(a.ws + R_UPRE); const float* cw = a.in[12]; const float* cb = a.in[13];
    for (int it = F.gw; it < 4 * 3 * 16 * 128; it += F.NGW) {
        const int tb = it & 127, cbk = (it >> 7) & 15, part = (it >> 11) % 3, b = it / (3 * 2048);
        const int col = part * 1024 + cbk * 64 + F.lane; const int t0 = tb * 64;
        bf16_t* dst = (bf16_t*)(a.ws + (part == 0 ? WS_H : part == 1 ? R_X1 : R_X2)) + ((size_t)(b * 1024 + cbk * 64 + F.lane)) * SEQ + t0;
        const float w0 = cw[col], w1 = cw[3072 + col], w2 = cw[6144 + col], bb = cb[col];
        const bf16_t* sp = Up + ((size_t)b * SEQ + t0) * 3072 + col;
        unsigned short pv[66];
#pragma unroll
        for (int i = 0; i < 66; ++i) { const int t = t0 - 1 + i; pv[i] = (t >= 0 && t < SEQ) ? sp[(ptrdiff_t)(i - 1) * 3072] : (unsigned short)0; }
#pragma unroll
        for (int q = 0; q < 8; ++q) {
            float o[8];
#pragma unroll
            for (int e = 0; e < 8; ++e) { const int tt = q * 8 + e; o[e] = bf2f(pv[tt]) * w0 + bf2f(pv[tt + 1]) * w1 + bf2f(pv[tt + 2]) * w2 + bb; }
            *(u32x4*)(dst + q * 8) = (u32x4){pk2(o[0], o[1]), pk2(o[2], o[3]), pk2(o[4], o[5]), pk2(o[6], o[7])};
        }
    }
}
__device__ __forceinline__ void phase_hytr(const Ctx& F, const Args& a) {
    const bf16_t* Z2 = (const bf16_t*)(a.ws + R_Z2); bf16_t* H = (bf16_t*)(a.ws + R_Z2T);
    for (int it = F.gw; it < 4 * 16 * 128; it += F.NGW) {
        const int tb = it & 127, cbk = (it >> 7) & 15, b = it >> 11; const int t0 = tb * 64, c = cbk * 64 + F.lane;
        const bf16_t* sp = Z2 + ((size_t)(b * 1024 + c)) * SEQ + t0; bf16_t* dp = H + ((size_t)b * SEQ + t0) * 1024 + c;
        u32x4 wq[8];
#pragma unroll
        for (int q = 0; q < 8; ++q) wq[q] = *(const u32x4*)(sp + q * 8);
#pragma unroll
        for (int q = 0; q < 8; ++q) { const u32x4 w = wq[q]; bf16_t* d = dp + (size_t)(q * 8) * 1024;
            d[0] = (bf16_t)(w.x & 0xffff); d[1024] = (bf16_t)(w.x >> 16); d[2048] = (bf16_t)(w.y & 0xffff); d[3072] = (bf16_t)(w.y >> 16);
            d[4096] = (bf16_t)(w.z & 0xffff); d[5120] = (bf16_t)(w.z >> 16); d[6144] = (bf16_t)(w.w & 0xffff); d[7168] = (bf16_t)(w.w >> 16); }
    }
}

constexpr int FN = 16384;
constexpr int A2S = SEQ + 64;
__device__ __forceinline__ int fswz(int i) { return i ^ ((i >> 5) & 31); }
__host__ __device__ constexpr float cos16(int k) { k &= 15; return k == 0 ? 1.f : k == 1 ? 0.92387953251f : k == 2 ? 0.70710678119f : k == 3 ? 0.38268343237f : k == 4 ? 0.f : k == 5 ? -0.38268343237f : k == 6 ? -0.70710678119f : k == 7 ? -0.92387953251f
    : k == 8 ? -1.f : k == 9 ? -0.92387953251f : k == 10 ? -0.70710678119f : k == 11 ? -0.38268343237f : k == 12 ? 0.f : k == 13 ? 0.38268343237f : k == 14 ? 0.70710678119f : 0.92387953251f; }
__host__ __device__ constexpr float sin16(int k) { return cos16(k + 12); }
template <int R, int LSTR, bool INV, int NG>
__device__ __forceinline__ void fft_stages(f32x2 (&v)[NG][1 << R], const int (&jv)[NG]) {
    constexpr int NE = 1 << R;
#pragma unroll
    for (int rr = 0; rr < R; ++rr) {
        const int r = INV ? (R - 1 - rr) : rr; const int dq = 1 << (R - 1 - r);
#pragma unroll
        for (int gI = 0; gI < NG; ++gI) {
            const float fr0 = (float)jv[gI] * (1.0f / (float)(1 << (LSTR + R - r)));
            const float cs = __builtin_amdgcn_cosf(fr0), sn = __builtin_amdgcn_sinf(fr0);
            const f32x2 w0 = {cs, INV ? sn : -sn};
#pragma unroll
            for (int q = 0; q < NE; ++q) if (!(q & dq)) {
                const int m = q & (dq - 1); const int k16 = m << (4 - (R - r));
                const float cr = cos16(k16), ci = INV ? sin16(k16) : -sin16(k16);
                f32x2 tw; if (m == 0) tw = w0; else tw = w0 * cr + (f32x2){-w0.y, w0.x} * ci;
                const f32x2 twp = {-tw.y, tw.x};
                const f32x2 x = v[gI][q], y = v[gI][q + dq];
                if (!INV) { const f32x2 d = x - y; v[gI][q] = x + y; v[gI][q + dq] = twp * d.y + tw * d.x; }
                else { const f32x2 yt = twp * y.y + tw * y.x; v[gI][q] = x + yt; v[gI][q + dq] = x - yt; }
            }
        }
    }
}
template <int R, int LSTR, bool INV>
__device__ __forceinline__ void fft_pass(LAS f32x2* cb, int tid) {
    constexpr int NE = 1 << R, STR = 1 << LSTR, NG = (R == 4) ? 2 : 1;
#pragma unroll 1
    for (int gi = tid; gi < (FN >> R); gi += 512 * NG) {
        int g2 = gi; asm volatile("" : "+v"(g2));
        int jv[NG], base[NG];
#pragma unroll
        for (int gI = 0; gI < NG; ++gI) { const int gg = g2 + 512 * gI; jv[gI] = gg & (STR - 1); base[gI] = ((gg >> LSTR) << (LSTR + R)) + jv[gI]; }
        f32x2 v[NG][NE];
#pragma unroll
        for (int gI = 0; gI < NG; ++gI)
#pragma unroll
            for (int q = 0; q < NE; ++q) v[gI][q] = cb[fswz(base[gI] + (q << LSTR))];
        fft_stages<R, LSTR, INV, NG>(v, jv);
#pragma unroll
        for (int gI = 0; gI < NG; ++gI)
#pragma unroll
            for (int q = 0; q < NE; ++q) cb[fswz(base[gI] + (q << LSTR))] = v[gI][q];
    }
    __syncthreads();
}
__device__ __forceinline__ void fft_fwd(LAS f32x2* cb, int tid) { fft_pass<4, 10, false>(cb, tid); fft_pass<4, 6, false>(cb, tid); fft_pass<4, 2, false>(cb, tid); fft_pass<2, 0, false>(cb, tid); }
__device__ __forceinline__ void fft_inv(LAS f32x2* cb, int tid) { fft_pass<2, 0, true>(cb, tid); fft_pass<4, 2, true>(cb, tid); fft_pass<4, 6, true>(cb, tid); fft_pass<4, 10, true>(cb, tid); }

__device__ __forceinline__ void fft_mid(LAS f32x2* cb, const f32x2* __restrict__ KFo, int tid) {
    f32x4 kk[16];
    { int tq = tid; asm volatile("" : "+v"(tq)); tid = tq; }
#pragma unroll
    for (int i = 0; i < 8; ++i) { const f32x2* kp = KFo + (size_t)(tid + 512 * i) * 4; kk[2 * i] = *(const f32x4*)kp; kk[2 * i + 1] = *(const f32x4*)(kp + 2); }
#pragma unroll
    for (int i = 0; i < 8; ++i) {
        const int base = (tid + 512 * i) << 2;
        f32x2 v[4]; f32x2 k[4];
#pragma unroll
        for (int q = 0; q < 4; ++q) v[q] = cb[fswz(base + q)];
        k[0] = (f32x2){kk[2 * i].x, kk[2 * i].y}; k[1] = (f32x2){kk[2 * i].z, kk[2 * i].w}; k[2] = (f32x2){kk[2 * i + 1].x, kk[2 * i + 1].y}; k[3] = (f32x2){kk[2 * i + 1].z, kk[2 * i + 1].w};
        { const f32x2 a = v[0] + v[2], b = v[0] - v[2], c = v[1] + v[3], d = v[1] - v[3]; const f32x2 dm = {d.y, -d.x};
          v[0] = a + c; v[1] = a - c; v[2] = b + dm; v[3] = b - dm; }
#pragma unroll
        for (int q = 0; q < 4; ++q) { const f32x2 z = v[q]; v[q] = k[q] * z.x + (f32x2){-k[q].y, k[q].x} * z.y; }
        { const f32x2 a = v[0] + v[1], b = v[0] - v[1], c = v[2] + v[3], d = v[2] - v[3]; const f32x2 dp = {-d.y, d.x};
          v[0] = a + c; v[2] = a - c; v[1] = b + dp; v[3] = b - dp; }
#pragma unroll
        for (int q = 0; q < 4; ++q) cb[fswz(base + q)] = v[q];
    }
    __syncthreads();
}
__device__ __forceinline__ void fft_fwd3(LAS f32x2* cb, int tid) { fft_pass<4, 10, false>(cb, tid); fft_pass<4, 6, false>(cb, tid); fft_pass<4, 2, false>(cb, tid); }
__device__ __forceinline__ void fft_inv3(LAS f32x2* cb, int tid) { fft_pass<4, 2, true>(cb, tid); fft_pass<4, 6, true>(cb, tid); fft_pass<4, 10, true>(cb, tid); }
__device__ __forceinline__ float block_sum(float v, LAS float* red, int tid) {
    v = wave_sum(v, tid & 63); __syncthreads(); if ((tid & 63) == 0) red[tid >> 6] = v; __syncthreads();
    float s = 0.f;
#pragma unroll
    for (int w = 0; w < 8; ++w) s += red[w];
    return s;
}
__device__ __forceinline__ void hy_conv16(const bf16_t* rowp, int t0, float w0, float w1, float w2, float bb, float (&out)[16]) {
    const u32x4 a0 = *(const u32x4*)(rowp + t0), a1 = *(const u32x4*)(rowp + t0 + 8);
    const float lft = (t0 > 0) ? bf2f(rowp[t0 - 1]) : 0.f, rgt = (t0 + 16 < SEQ) ? bf2f(rowp[t0 + 16]) : 0.f;
    float p[18]; p[0] = lft; p[17] = rgt;
#pragma unroll
    for (int e = 0; e < 4; ++e) { p[1 + 2 * e] = bflo(a0[e]); p[2 + 2 * e] = bfhi(a0[e]); p[9 + 2 * e] = bflo(a1[e]); p[10 + 2 * e] = bfhi(a1[e]); }
#pragma unroll
    for (int e = 0; e < 16; ++e) out[e] = w0 * p[e] + w1 * p[e + 1] + w2 * p[e + 2] + bb;
}
__device__ __forceinline__ void phase_hyfft(const Ctx& F, const Args& a) {
    LAS f32x2* cb = (LAS f32x2*)F.lds; LAS float* red = (LAS float*)(F.lds + MISC_OFF); LAS f32x4* w3l = (LAS f32x4*)(F.lds + MISC_OFF + 256);
    const float* A2 = (const float*)(a.ws + WS_A2); const float* w3 = a.in[18]; const float* skip = a.in[20];
    const bf16_t* UT = (const bf16_t*)(a.ws + R_UPRE); const float* cwp = a.in[12]; const float* cbp = a.in[13];
    float* Z1 = (float*)(a.ws + R_Z1S) + (size_t)F.bid * 4 * SEQ; f32x2* KF = (f32x2*)(a.ws + R_KFS) + (size_t)F.bid * 2 * FN; bf16_t* Z2 = (bf16_t*)(a.ws + R_Z2);
    const int tid = F.tid;
    for (int d = F.bid; d < DM; d += F.G) {
        __syncthreads();
        if (tid < 64) w3l[tid] = (f32x4){w3[tid * 4096 + d], w3[tid * 4096 + 1024 + d], w3[tid * 4096 + 2048 + d], w3[tid * 4096 + 3072 + d]};
        __syncthreads();
        const float dlo = -3.0701134573253946f, dhi = -15.350567286626973f; const float delta = fabsf(dlo + (float)d * ((dhi - dlo) / 1023.0f));
        float n0 = 0.f, n1 = 0.f;
        {
            f32x4 acc[16];
#pragma unroll
            for (int i = 0; i < 16; ++i) acc[i] = (f32x4){0.f, 0.f, 0.f, 0.f};
            int tq = tid; asm volatile("" : "+v"(tq));
            const float* ap = A2 + 4 * tq;
            f32x4 bA[8], bB[8];
#define HY_LD(buf, c) do { _Pragma("unroll") for (int jl = 0; jl < 2; ++jl) _Pragma("unroll") for (int i = 0; i < 4; ++i) buf[jl * 4 + i] = *(const f32x4*)(ap + (size_t)((c) * 2 + jl) * A2S + 2048 * i); } while (0)
#define HY_CP(buf, c) do { _Pragma("unroll") for (int jl = 0; jl < 2; ++jl) { const f32x4 w = w3l[(c) * 2 + jl]; _Pragma("unroll") for (int i = 0; i < 4; ++i) { const f32x4 av = buf[jl * 4 + i]; \
                acc[i * 4 + 0] = acc[i * 4 + 0] + w * av.x; acc[i * 4 + 1] = acc[i * 4 + 1] + w * av.y; acc[i * 4 + 2] = acc[i * 4 + 2] + w * av.z; acc[i * 4 + 3] = acc[i * 4 + 3] + w * av.w; } } } while (0)
            f32x4 bC[8];
            HY_LD(bA, 0); HY_LD(bB, 1);
#pragma unroll 1
            for (int c = 0; c < 30; c += 3) { HY_LD(bC, c + 2); HY_CP(bA, c); HY_LD(bA, c + 3); HY_CP(bB, c + 1); HY_LD(bB, c + 4); HY_CP(bC, c + 2); }
            HY_CP(bA, 30); HY_CP(bB, 31);
#undef HY_LD
#undef HY_CP
#pragma unroll
            for (int i = 0; i < 4; ++i)
#pragma unroll
                for (int e = 0; e < 4; ++e) { const int t = 4 * tq + 2048 * i + e;
                    const float dec = expf(-((float)t * (1.0f / (float)(SEQ - 1))) * delta); const f32x4 sv = acc[i * 4 + e] * dec;
                    cb[fswz(t)] = (f32x2){sv.x, sv.z}; n0 += fabsf(sv.x); n1 += fabsf(sv.z);
                    if (t > 0) { cb[fswz(2 * SEQ - t)] = (f32x2){sv.y, sv.w}; n0 += fabsf(sv.y); n1 += fabsf(sv.w); } else { float z = 0.f; asm volatile("" : "+v"(z)); cb[fswz(SEQ)] = (f32x2){z, z}; } }
        }
        n0 = block_sum(n0, red, tid); n1 = block_sum(n1, red, tid);
        __syncthreads();
        fft_fwd(cb, tid);
        { const float s0 = 0.5f / (n0 * (float)FN), s1 = 0.5f / (n1 * (float)FN);
#pragma unroll 2
          for (int p0_ = tid; p0_ < FN; p0_ += 512) { int p = p0_; asm volatile("" : "+v"(p)); const int f = (int)(__brev((unsigned)p) >> 18); const int p2 = (int)(__brev((unsigned)((FN - f) & (FN - 1))) >> 18);
              const f32x2 z = cb[fswz(p)], zc = cb[fswz(p2)];
              KF[p] = (f32x2){(z.x + zc.x) * s0, (z.y - zc.y) * s0};
              KF[FN + p] = (f32x2){(z.y + zc.y) * s1, -(z.x - zc.x) * s1}; } }
        __syncthreads();
        const float sk0 = skip[d], sk1 = skip[1024 + d];
        const float cv0 = cwp[d], cv1 = cwp[3072 + d], cv2 = cwp[6144 + d], cvb = cbp[d];
        const float c10 = cwp[1024 + d], c11 = cwp[3072 + 1024 + d], c12 = cwp[6144 + 1024 + d], c1b = cbp[1024 + d];
        const float c20 = cwp[2048 + d], c21 = cwp[3072 + 2048 + d], c22 = cwp[6144 + 2048 + d], c2b = cbp[2048 + d];
        const bf16_t* Vr = UT + (size_t)d * TOK; const bf16_t* X1r = UT + (size_t)(1024 + d) * TOK; const bf16_t* X2r = UT + (size_t)(2048 + d) * TOK;
#pragma unroll 1
        for (int o = 0; o < 2; ++o) {
#pragma unroll 1
            for (int pr = 0; pr < 2; ++pr) {
                const int b0 = 2 * pr, b1 = 2 * pr + 1;
                {   int tq = tid; asm volatile("" : "+v"(tq)); const int t0 = tq * 16; float zr[16], zi[16];
                    if (o == 0) { hy_conv16(Vr + (size_t)b0 * SEQ, t0, cv0, cv1, cv2, cvb, zr); hy_conv16(Vr + (size_t)b1 * SEQ, t0, cv0, cv1, cv2, cvb, zi); }
                    else { const f32x4* p0 = (const f32x4*)(Z1 + b0 * SEQ + t0); const f32x4* p1 = (const f32x4*)(Z1 + b1 * SEQ + t0);
#pragma unroll
                        for (int q = 0; q < 4; ++q) { const f32x4 a = p0[q], c = p1[q];
#pragma unroll
                            for (int e = 0; e < 4; ++e) { zr[4 * q + e] = a[e]; zi[4 * q + e] = c[e]; } } }
                    float z = 0.f; asm volatile("" : "+v"(z));
#pragma unroll
                    for (int e = 0; e < 16; ++e) { cb[fswz(t0 + e)] = (f32x2){zr[e], zi[e]}; cb[fswz(SEQ + t0 + e)] = (f32x2){z, z}; } }
                __syncthreads();
                fft_fwd3(cb, tid);
                fft_mid(cb, KF + o * FN, tid);
                fft_inv3(cb, tid);
                {   int tq = tid; asm volatile("" : "+v"(tq)); const int t0 = tq * 16; const size_t i0 = ((size_t)(b0 * 1024 + d)) * SEQ + t0, i1 = ((size_t)(b1 * 1024 + d)) * SEQ + t0;
                    float y0[16], y1[16];
                    if (o == 0) {
                        float xa[16], xb[16], va[16], vb[16];
                        hy_conv16(X1r + (size_t)b0 * SEQ, t0, c10, c11, c12, c1b, xa); hy_conv16(X1r + (size_t)b1 * SEQ, t0, c10, c11, c12, c1b, xb);
                        hy_conv16(Vr + (size_t)b0 * SEQ, t0, cv0, cv1, cv2, cvb, va); hy_conv16(Vr + (size_t)b1 * SEQ, t0, cv0, cv1, cv2, cvb, vb);
#pragma unroll
                        for (int e = 0; e < 16; ++e) { const f32x2 y = cb[fswz(t0 + e)]; y0[e] = xa[e] * (y.x + sk0 * va[e]); y1[e] = xb[e] * (y.y + sk0 * vb[e]); }
                        f32x4* q0 = (f32x4*)(Z1 + b0 * SEQ + t0); f32x4* q1 = (f32x4*)(Z1 + b1 * SEQ + t0);
#pragma unroll
                        for (int q = 0; q < 4; ++q) { q0[q] = (f32x4){y0[4 * q], y0[4 * q + 1], y0[4 * q + 2], y0[4 * q + 3]}; q1[q] = (f32x4){y1[4 * q], y1[4 * q + 1], y1[4 * q + 2], y1[4 * q + 3]}; }
                    } else {
                        float xa[16], xb[16];
                        hy_conv16(X2r + (size_t)b0 * SEQ, t0, c20, c21, c22, c2b, xa); hy_conv16(X2r + (size_t)b1 * SEQ, t0, c20, c21, c22, c2b, xb);
                        const f32x4* z0 = (const f32x4*)(Z1 + b0 * SEQ + t0); const f32x4* z1p = (const f32x4*)(Z1 + b1 * SEQ + t0);
                        float za[16], zb[16];
#pragma unroll
                        for (int q = 0; q < 4; ++q) { const f32x4 a = z0[q], c = z1p[q];
#pragma unroll
                            for (int e = 0; e < 4; ++e) { za[4 * q + e] = a[e]; zb[4 * q + e] = c[e]; } }
#pragma unroll
                        for (int e = 0; e < 16; ++e) { const f32x2 y = cb[fswz(t0 + e)]; y0[e] = xa[e] * (y.x + sk1 * za[e]); y1[e] = xb[e] * (y.y + sk1 * zb[e]); }
                        u32x4 oa0, oa1, ob0, ob1;
#pragma unroll
                        for (int e = 0; e < 4; ++e) { oa0[e] = pk2(y0[2 * e], y0[2 * e + 1]); oa1[e] = pk2(y0[8 + 2 * e], y0[9 + 2 * e]); ob0[e] = pk2(y1[2 * e], y1[2 * e + 1]); ob1[e] = pk2(y1[8 + 2 * e], y1[9 + 2 * e]); }
                        *(u32x4*)(Z2 + i0) = oa0; *(u32x4*)(Z2 + i0 + 8) = oa1; *(u32x4*)(Z2 + i1) = ob0; *(u32x4*)(Z2 + i1 + 8) = ob1;
                    }
                }
                __syncthreads();
            }
        }
    }
}

__device__ __forceinline__ void phase_s5prep(const Ctx& F, const Args& a) {
    const float* KT = (const float*)(a.ws + WS_KTAB); const f32x2* LP = (const f32x2*)(a.ws + WS_LP); const f32x2* BB = (const f32x2*)(a.ws + WS_BBAR);
    const float *Cre = a.in[27], *Cim = a.in[28], *Dsk = a.in[29];
    bf16_t* Bt = (bf16_t*)(a.ws + R_BT1); bf16_t* Cm = (bf16_t*)(a.ws + R_CM);
    for (int it = F.gw; it < 64 * 512; it += F.NGW) {
        const int g = it >> 9, n = it & 511, to = n >> 4, ho = n & 15; const int k0 = F.lane * 8, ti = k0 >> 4, hi0 = k0 & 15;
        float o[8];
#pragma unroll
        for (int e = 0; e < 8; ++e) { float v = 0.f;
            if (to >= ti) v += KT[(((size_t)(g * 2 + 0) * 32 + (to - ti)) * 16 + ho) * 16 + hi0 + e];
            if (ti >= to) v += KT[(((size_t)(g * 2 + 1) * 32 + (ti - to)) * 16 + ho) * 16 + hi0 + e];
            if (ti == to && hi0 + e == ho) v += Dsk[g * 16 + ho];
            o[e] = v; }
        *(u32x4*)(Bt + ((size_t)g * 768 + n) * 512 + k0) = (u32x4){pk2(o[0], o[1]), pk2(o[2], o[3]), pk2(o[4], o[5]), pk2(o[6], o[7])};
    }
    for (int it = F.gw; it < 64 * 256; it += F.NGW) {
        const int g = it >> 8, np = it & 255, dir = np >> 7, im = (np >> 6) & 1, p = np & 63; const int k0 = F.lane * 8, tl = k0 >> 4, hi0 = k0 & 15;
        const int pw = dir ? tl : 31 - tl; const f32x2 l = LP[((size_t)(g * 2 + dir) * 33 + pw) * 64 + p];
        float o[8];
#pragma unroll
        for (int e = 0; e < 8; ++e) { const f32x2 b = BB[((size_t)(g * 2 + dir) * 64 + p) * 16 + hi0 + e]; o[e] = im ? (l.x * b.y + l.y * b.x) : (l.x * b.x - l.y * b.y); }
        *(u32x4*)(Bt + ((size_t)g * 768 + 512 + np) * 512 + k0) = (u32x4){pk2(o[0], o[1]), pk2(o[2], o[3]), pk2(o[4], o[5]), pk2(o[6], o[7])};
    }
    for (int it = F.gw; it < 64 * 512; it += F.NGW) {
        const int g = it >> 9, n = it & 511, tl = n >> 4, ho = n & 15;
#pragma unroll
        for (int q = 0; q < 4; ++q) { const int kp = q * 64 + F.lane, dir = kp >> 7, im = (kp >> 6) & 1, p = kp & 63; const int pw = dir ? 32 - tl : tl + 1;
            const f32x2 l = LP[((size_t)(g * 2 + dir) * 33 + pw) * 64 + p]; const size_t ci = ((size_t)(dir * 64 + g) * 16 + ho) * 64 + p; const float cr = Cre[ci], cm = Cim[ci];
            const float v = im ? -(cr * l.y + cm * l.x) : (cr * l.x - cm * l.y);
            Cm[((size_t)g * 512 + n) * 256 + kp] = (bf16_t)f2bf(v); }
    }
}
__device__ __forceinline__ void phase_s5scan(const Ctx& F, const Args& a) {
    const float* S = (const float*)(a.ws + R_S); bf16_t* Xc = (bf16_t*)(a.ws + R_XC); const f32x2* LP = (const f32x2*)(a.ws + WS_LP);
    for (int it = F.gw; it < 64 * 2 * 4; it += F.NGW) {
        const int b = it & 3, dir = (it >> 2) & 1, g = it >> 3, p = F.lane;
        const f32x2 l = LP[((size_t)(g * 2 + dir) * 33 + 32) * 64 + p];
        float xr = 0.f, xi = 0.f;
        const size_t base = ((size_t)g * 1024 + b * 256) * 256 + dir * 128 + p;
#pragma unroll 1
        for (int c0 = 0; c0 < 256; c0 += 16) {
            float sr[16], si[16];
#pragma unroll
            for (int k = 0; k < 16; ++k) { const int c = dir ? 255 - (c0 + k) : (c0 + k); const size_t o = base + (size_t)c * 256; sr[k] = S[o]; si[k] = S[o + 64]; }
#pragma unroll
            for (int k = 0; k < 16; ++k) { const int c = dir ? 255 - (c0 + k) : (c0 + k); const size_t o = base + (size_t)c * 256;
                Xc[o] = (bf16_t)f2bf(xr); Xc[o + 64] = (bf16_t)f2bf(xi);
                const float nr = l.x * xr - l.y * xi + sr[k], ni = l.x * xi + l.y * xr + si[k]; xr = nr; xi = ni; }
        }
    }
}

#define GAS __attribute__((address_space(1)))
typedef GAS unsigned gu32;
#define XB_TMO      128
#define XB_XCNT(j)  (256  + 64 * (j))
#define XB_XSUB(j)  (1280 + 64 * (j))
#define XB_XGEN(j)  (2304 + 64 * (j))
#define XB_TOP      3328
#define XB_TOPGEN   3392
#define XCD_BAR_WORDS 3456
#define XB_SPIN_CAP (1u << 18)

__device__ __forceinline__ unsigned xb_ld(unsigned* p)              { return __hip_atomic_load(p, __ATOMIC_RELAXED, __HIP_MEMORY_SCOPE_AGENT); }
__device__ __forceinline__ unsigned xb_add(unsigned* p, unsigned v) { return __hip_atomic_fetch_add(p, v, __ATOMIC_RELAXED, __HIP_MEMORY_SCOPE_AGENT); }
__device__ __forceinline__ unsigned xb_xcc_id() { return (unsigned)__builtin_amdgcn_s_getreg((3 << 11) | 20) & 0xFu; }
#define XB_SPIN(cond, bar) do { unsigned _sp = 0; while (cond) { __builtin_amdgcn_s_sleep(1); \
    if ((++_sp & 255u) == 0u) { if (xb_ld(&(bar)[XB_TMO])) break; if (_sp > XB_SPIN_CAP) { atomicAdd(&(bar)[XB_TMO], 1u); break; } } } } while (0)

struct XcdBarrier {
    unsigned* bar; unsigned x;
    volatile LAS unsigned* st;
};

__device__ __forceinline__ XcdBarrier xcd_barrier_post(unsigned* bar, volatile LAS unsigned* st) {
    XcdBarrier b; b.bar = bar; b.x = xb_xcc_id(); b.st = st;
    if (threadIdx.x == 0) (void)xb_add(&bar[XB_XCNT(b.x)], 1u);
    return b;
}
__device__ __forceinline__ void xcd_barrier_complete(unsigned* bar, unsigned x, unsigned& nloc, unsigned& nx) {
    const unsigned G = gridDim.x * gridDim.y * gridDim.z;
    unsigned sum, cnt, mine, sp = 0u;
    for (;;) {
        sum = 0u; cnt = 0u; mine = 0u;
#pragma unroll
        for (unsigned j = 0; j < 16; ++j) { const unsigned c = xb_ld(&bar[XB_XCNT(j)]); sum += c; cnt += (c > 0u) ? 1u : 0u; mine = (j == x) ? c : mine; }
        if (sum == G) break;
        __builtin_amdgcn_s_sleep(1);
        if ((++sp & 255u) == 0u) { if (xb_ld(&bar[XB_TMO])) break; if (sp > XB_SPIN_CAP) { atomicAdd(&bar[XB_TMO], 1u); break; } }
    }
    nloc = mine > 0u ? mine : 1u; nx = cnt > 0u ? cnt : 1u;
}

__device__ __forceinline__ void xcd_barrier(const XcdBarrier& b) {
    asm volatile("s_waitcnt vmcnt(0)" ::: "memory");
    __syncthreads();
    if (threadIdx.x == 0) {
        unsigned* bar = b.bar;
        __builtin_amdgcn_s_waitcnt(0);
        unsigned nloc = b.st[0], nx = b.st[1];
        if (nloc == 0u) { xcd_barrier_complete(bar, b.x, nloc, nx); b.st[0] = nloc; b.st[1] = nx; }
        const unsigned old = xb_add(&bar[XB_XSUB(b.x)], 1u);
        const unsigned gen = old / nloc;
        if (old + 1u == (gen + 1u) * nloc) {
            __builtin_amdgcn_fence(__ATOMIC_RELEASE, "agent");
            asm volatile("s_waitcnt vmcnt(0)" ::: "memory");
            const unsigned og = xb_add(&bar[XB_TOP], 1u);
            const unsigned tg = og / nx;
            if (og + 1u == (tg + 1u) * nx) xb_add(&bar[XB_TOPGEN], 1u);
            else XB_SPIN(xb_ld(&bar[XB_TOPGEN]) == tg, bar);
            __builtin_amdgcn_fence(__ATOMIC_ACQUIRE, "agent");
            xb_add(&bar[XB_XGEN(b.x)], 1u);
            asm volatile("s_waitcnt vmcnt(0)" ::: "memory");
        } else {
            XB_SPIN(xb_ld(&bar[XB_XGEN(b.x)]) == gen, bar);
            __builtin_amdgcn_fence(__ATOMIC_ACQUIRE, "agent");
            asm volatile("s_waitcnt vmcnt(0)" ::: "memory");
        }
    }
    __syncthreads();
}

__device__ __forceinline__ pg8::Gemm std_gemm(const void* A, int lda, const void* Bt, int K) {
    pg8::Gemm g; g.A = (const char*)A; g.B = (const char*)Bt; g.nt = K / 64; g.a_row = lda; g.a_seg = 16; g.a_kstep = 128; g.a_g = 0; g.ldb = K; g.b_g = 0; return g;
}
__global__ void __launch_bounds__(NWAVES * 64, 2) mk_fwd(Args args0) {
    extern __shared__ __attribute__((aligned(16))) unsigned char lds[];
    cg::grid_group grid = cg::this_grid();
    const int ph_lo = args0.ph_lo, ph_hi = args0.ph_hi;
    volatile LAS unsigned* MISC = (volatile LAS unsigned*)((LAS unsigned char*)lds + MISC_OFF + 8192);
    if (threadIdx.x < 32) MISC[threadIdx.x] = 0u;
    __syncthreads();
    (void)xcd_barrier_post((unsigned*)(args0.ws + WS_BAR), MISC + 8);
    for (int ph = ph_lo; ph < ph_hi; ++ph) {
        typedef const __attribute__((address_space(4))) Args* KArgs;
        KArgs kap = (KArgs)__builtin_amdgcn_kernarg_segment_ptr(); asm volatile("" : "+s"(kap));
        const Args& args = *(const Args*)kap;
        Ctx F; F.lds = (LAS unsigned char*)lds; F.tid = ltid(); F.lane = F.tid & 63; F.wave = __builtin_amdgcn_readfirstlane(F.tid >> 6);
        const int bx = lbid(); F.G = lgrid(); F.bid = bx; F.vcu = (F.G % 8 == 0) ? (bx % 8) * (F.G / 8) + bx / 8 : bx;
        F.gw = bx * NWAVES + F.wave; F.NGW = F.G * NWAVES;
        unsigned char* ws = args.ws; bf16_t* Wb = (bf16_t*)(ws + WS_W); const float* mod = (const float*)(ws + WS_MOD);
        float* SSb = (float*)(ws + WS_SS); const float* BIASb = (const float*)(ws + WS_BIAS);
#define NEXTNORM(ln, wn, dst) pg8::NextNorm{(bf16_t*)(dst), ((wn) ? args.in[5] : args.in[4]) + (ln) * 1024, mod + (size_t)(ln) * 4 * 6144 + (wn) * 3072 + 1024, SSb + (size_t)(2 * (ln) + (wn)) * TOK}
        const int kind = args.prog[ph][0], layer = args.prog[ph][1], aux = args.prog[ph][2], j = args.prog[ph][3] & 1, nobar = args.prog[ph][3] >> 7;
#ifndef PH_MASK
#define PH_MASK 0xffffffffu
#endif
#define EN(k) (((PH_MASK) >> (k)) & 1u)
        switch (kind) {
        case K_PRO: if (EN(K_PRO)) { phase_prologue(F, args); } break;
        case K_MODRED: if (EN(K_MODRED)) { phase_modred(F, args); } break;
        case K_NORMMOD: if (EN(K_NORMMOD)) { phase_normmod(F, args, layer, aux); if (layer == 0 && aux == 0) { phase_bias(F, args); phase_modred(F, args); } } break;
        case K_QKN: if (EN(K_QKN)) { phase_qknorm(F, args, j); } break;
        case K_ATT: if (EN(K_ATT)) { const attn_body::AttnTensors AT{(const attn_body::bf16*)(ws + R_QN), (const attn_body::bf16*)(ws + R_KN), (const attn_body::bf16*)(ws + R_VC), (attn_body::bf16*)(ws + (aux ? R_QKV : R_QN))};
            const attn_body::StaticOrder S((int)F.G, bx);
            if (F.wave >= 4) __builtin_amdgcn_s_setprio(1);
            attn_body::attn_phase<attn_body::StaticOrder>((char*)lds, AT, S);
            __builtin_amdgcn_s_setprio(0); } break;
        case K_FFNCONV: if (EN(K_FFNCONV)) { phase_ffnfix(F, args, layer); } break;
        case K_HCT: if (EN(K_HCT)) { phase_hyconvT(F, args); } break;
        case K_HFFT: if (EN(K_HFFT)) { phase_hyfft(F, args); } break;
        case K_HTR: if (EN(K_HTR)) { phase_hytr(F, args); } break;
        case K_S5PREP: if (EN(K_S5PREP)) { phase_s5prep(F, args); } break;
        case K_S5SCAN: if (EN(K_S5SCAN)) { phase_s5scan(F, args); } break;
        case K_FINAL: if (EN(K_FINAL)) { phase_final(F, args); } break;
        case K_GEMM_HIN: if (EN(K_GEMM_HIN)) {
            pg8::Gemm g = std_gemm(Wb + WO_HIN, 1024, ws + WS_H, 1024); pg8::Sched S{3072 / 256, TOK / 256, 1, F.G, bx};
            pg8::EpiBf16T E{(bf16_t*)(ws + R_UPRE), SSb + (size_t)(2 * layer) * TOK, BIASb + 22528};
            pg8::gemm_phase<pg8::EpiBf16T>(F.lds, g, S, E); } break;
        case K_GEMM_WO: case K_GEMM_DN: case K_GEMM_HOUT: if (EN(K_GEMM_WO)) {
            pg8::Gemm g; pg8::Sched S; pg8::EpiRes E;
            if (kind == K_GEMM_WO) { g = std_gemm(ws + R_QN, 1024, Wb + WO_WO(j), 1024); S = pg8::Sched{TOK / 256, 4, 1, F.G, bx}; E = pg8::EpiRes{args.out, mod + (size_t)layer * 4 * 6144 + 2048, 0, NEXTNORM(layer, 1, ws + WS_H), layer == 0 ? args.in[0] : args.out}; }
            else if (kind == K_GEMM_HOUT) { g = std_gemm(ws + R_Z2T, 1024, Wb + WO_HOUT, 1024); S = pg8::Sched{TOK / 256, 4, 1, F.G, bx}; E = pg8::EpiRes{args.out, mod + (size_t)layer * 4 * 6144 + 2048, 0, NEXTNORM(layer, 1, ws + R_H2), args.out}; }
            else { g = std_gemm(ws + R_G, DFF, Wb + WO_DN(layer), DFF); S = pg8::Sched{TOK / 256, 4, 1, F.G, bx}; E = pg8::EpiRes{args.out, mod + (size_t)layer * 4 * 6144 + 5120, 0, pg8::NextNorm{nullptr, nullptr, nullptr, nullptr}, args.out};
                if (layer < 3) { E.nn = NEXTNORM(layer + 1, 0, ws + WS_H); if (layer == 1) { E.nn.Hn = nullptr; E.nn.ssn = nullptr; } } }
            if (aux) { E.X = (float*)(ws + WS_R + 200 * MiB); E.Xr = E.X; }
            pg8::gemm_phase<pg8::EpiRes>(F.lds, g, S, E); } break;
        case K_GEMM_QKV: if (EN(K_GEMM_QKV)) { pg8::Gemm g = std_gemm(ws + WS_H, 1024, Wb + WO_QKV(j), 1024); pg8::Sched S{TOK / 256, NQKV / 256, 1, F.G, bx};
            pg8::EpiQkv E{(bf16_t*)(ws + R_QN), (bf16_t*)(ws + R_KN), (bf16_t*)(ws + R_VC), SSb + (size_t)(2 * layer) * TOK, layer == 0 ? SSb + (size_t)4 * TOK : BIASb + 25600, layer == 0 ? 0 : pg8::NBIAS,
                          args.in[9] + j * 64, args.in[10] + j * 64, (const f32x2*)(ws + WS_ROPE), (LAS float*)(F.lds + MISC_OFF + 1024), (LAS float*)(F.lds + MISC_OFF + 9216)};
            pg8::gemm_phase<pg8::EpiQkv>(F.lds, g, S, E); } break;
        case K_GEMM_UP: if (EN(K_GEMM_UP)) { pg8::Gemm g = std_gemm(layer == 1 ? ws + R_H2 : ws + WS_H, 1024, Wb + WO_UP(layer), 1024); pg8::Sched S{TOK / 256, 5632 / 256, 1, F.G, bx};
            pg8::EpiFfn E{(bf16_t*)(ws + R_G), (float*)(ws + R_HALO), args.in[32] + (size_t)layer * 3 * DFF, args.in[33] + (size_t)layer * DFF, (LAS float*)(F.lds + MISC_OFF + 1024), SSb + (size_t)(2 * layer + 1) * TOK, BIASb + (size_t)layer * 5632};
            pg8::gemm_phase<pg8::EpiFfn>(F.lds, g, S, E); } break;
        case K_GEMM_GLU: if (EN(K_GEMM_GLU)) { pg8::Gemm g = std_gemm(ws + R_YI, 1024, Wb + WO_GLU, 1024); pg8::Sched S{TOK / 256, 8, 1, F.G, bx}; pg8::EpiGlu E{args.out, mod + (size_t)layer * 4 * 6144 + 2048, NEXTNORM(layer, 1, ws + WS_H)};
            pg8::gemm_phase<pg8::EpiGlu>(F.lds, g, S, E); } break;
        case K_GEMM_S1: if (EN(K_GEMM_S1)) { pg8::Gemm g; g.A = (const char*)(ws + WS_H); g.B = (const char*)(ws + R_BT1); g.nt = 8; g.a_row = 32 * 1024; g.a_seg = 1024; g.a_kstep = 4 * 1024 * 2; g.a_g = 32; g.ldb = 512; g.b_g = (size_t)768 * 512 * 2;
            pg8::Sched S{4, 3, 64, F.G, bx}; pg8::EpiS1 E{(bf16_t*)(ws + R_YI), (float*)(ws + R_S)};
            pg8::gemm_phase<pg8::EpiS1>(F.lds, g, S, E); } break;
        case K_GEMM_S2: if (EN(K_GEMM_S2)) { pg8::Gemm g; g.A = (const char*)(ws + R_XC); g.B = (const char*)(ws + R_CM); g.nt = 4; g.a_row = 256; g.a_seg = 16; g.a_kstep = 128; g.a_g = (size_t)1024 * 256 * 2; g.ldb = 256; g.b_g = (size_t)512 * 256 * 2;
            pg8::Sched S{4, 2, 64, F.G, bx}; pg8::EpiS2 E{(bf16_t*)(ws + R_YI)};
            pg8::gemm_phase<pg8::EpiS2>(F.lds, g, S, E); } break;
        default: break;
        }
        if (ph + 1 < ph_hi && !nobar) { if (ph_hi < 0) grid.sync(); else { XcdBarrier bar; bar.bar = (unsigned*)(ws + WS_BAR); bar.x = xb_xcc_id(); bar.st = (volatile LAS unsigned*)((LAS unsigned char*)lds + MISC_OFF + 8192) + 8; xcd_barrier(bar); } } else if (nobar) __syncthreads();
    }
}

#ifndef MK_PER_PHASE
#define MK_PER_PHASE 0
#endif
extern "C" void kernel_launch(void* const* d_in, const int* in_sizes, int n_in, void* d_out, int out_size, void* d_ws, size_t ws_size, hipStream_t stream) {
    static int grid = 0;
    if (grid == 0) {
        if (n_in != 35 || out_size != TOK * DM || ws_size < WS_END) { fprintf(stderr, "kernel_launch: unexpected shapes (n_in %d out %d ws %zu)\n", n_in, out_size, ws_size); grid = -1; return; }
        int dev = 0, cus = 0, per_cu = 0;
        hipGetDevice(&dev); hipDeviceGetAttribute(&cus, hipDeviceAttributeMultiprocessorCount, dev);
        if (hipFuncSetAttribute((const void*)mk_fwd, hipFuncAttributeMaxDynamicSharedMemorySize, LDS_BYTES) != hipSuccess) { fprintf(stderr, "kernel_launch: hipFuncSetAttribute failed\n"); grid = -1; return; }
        if (hipOccupancyMaxActiveBlocksPerMultiprocessor(&per_cu, (const void*)mk_fwd, NWAVES * 64, LDS_BYTES) != hipSuccess || per_cu < 1) { fprintf(stderr, "kernel_launch: occupancy query gave %d\n", per_cu); per_cu = 1; }
        (void)hipGetLastError();
        grid = cus * 1;
    }
    if (grid < 0) return;
    Args a{};
    for (int i = 0; i < 35; ++i) a.in[i] = (const float*)d_in[i];
    a.out = (float*)d_out; a.ws = (unsigned char*)d_ws;
    int np = 0;
#ifndef PROBE_DUP
#define PROBE_DUP 0u
#endif
    auto P1 = [&](int kind, int layer, int aux, int j) { a.prog[np][0] = (unsigned char)kind; a.prog[np][1] = (unsigned char)layer; a.prog[np][2] = (unsigned char)aux; a.prog[np][3] = (unsigned char)j; ++np; };
    auto P = [&](int kind, int layer, int aux, int j) { if ((PROBE_DUP >> kind) & 1u) P1(kind, layer, (kind == K_ATT || kind == K_GEMM_WO || kind == K_GEMM_DN || kind == K_GEMM_HOUT) ? 1 : aux, j); P1(kind, layer, aux, j); };
    P(K_PRO, 0, 0, 0);
    for (int i = 0; i < 4; ++i) {
        const int m = i % 3, j = i / 3;
        if (m == 0) { if (i == 0) P(K_NORMMOD, i, 0, j); P(K_GEMM_QKV, i, 0, j); P(K_ATT, i, 0, j); P(K_GEMM_WO, i, 0, j); }
        else if (m == 1) { P(K_GEMM_HIN, i, 0, j); P(K_HFFT, i, 0, j); P(K_HTR, i, 0, j); P(K_GEMM_HOUT, i, 0, j); }
        else { P(K_NORMMOD, i, 0, j | 128); P(K_S5PREP, i, 0, j); P(K_GEMM_S1, i, 0, j);   P(K_S5SCAN, i, 0, j); P(K_GEMM_S2, i, 0, j); P(K_GEMM_GLU, i, 0, j); }
        P(K_GEMM_UP, i, 0, j); P(K_FFNCONV, i, 0, j); P(K_GEMM_DN, i, 0, j);
    }
    P(K_FINAL, 0, 0, 0);
#if MK_PER_PHASE
    for (int ph = 0; ph < np; ++ph) { a.ph_lo = ph; a.ph_hi = ph + 1; hipLaunchKernelGGL(mk_fwd, dim3(grid), dim3(NWAVES * 64), LDS_BYTES, stream, a); }
#else
    a.ph_lo = 0; a.ph_hi = np;
    (void)hipMemsetAsync((char*)d_ws + WS_MOD, 0, 4 * 4 * 6144 * 4 + 16384, stream);
    void* kargs[] = {&a};
    hipError_t e = hipLaunchCooperativeKernel((const void*)mk_fwd, dim3(grid), dim3(NWAVES * 64), kargs, LDS_BYTES, stream);
    if (e != hipSuccess) fprintf(stderr, "kernel_launch: cooperative launch failed: %s (grid %d)\n", hipGetErrorString(e), grid);
#endif
}
```
